# Optimizing an MI355X kernel written in HIP

```python
import math
import jax, jax.numpy as jnp
from jax import lax
import numpy as np

D_MODEL = 1024
BATCH = 8
SEQ = 2048
DEPTH = 2
DEC_BATCH = 128
DEC_SEQ = 4
PAST_LEN = 16384
PAGE_SIZE = 128

D_RNN = D_MODEL
LRU_HEADS = 16
LRU_BLOCK = D_RNN // LRU_HEADS
CONV_W = 4
LRU_C = 8.0
D_S5 = D_MODEL
S5_GROUP = 16
S5_GROUPS = D_S5 // S5_GROUP
S5_STATE = 64
S5_CHUNK = 128
D_FF = int(math.ceil(8 * D_MODEL / 3 / 256)) * 256
DN_ALPHA = (2 * DEPTH) ** 0.25
DN_BETA = (8 * DEPTH) ** -0.25
LN_EPS = 1e-5
N_ADA = 6
SPLITS = [D_RNN, 2 * D_RNN, 2 * D_RNN + D_S5, 2 * D_RNN + D_S5 + D_MODEL]
N_IN = 2 * D_RNN + D_S5 + 2 * D_MODEL

kernel_name = "hawk_s5_gated_hybrid_step"


def layer_norm(x, g, b):
    xf = x.astype(jnp.float32)
    mu = xf.mean(-1, keepdims=True)
    var = jnp.square(xf - mu).mean(-1, keepdims=True)
    y = (xf - mu) * lax.rsqrt(var + LN_EPS) * g.astype(jnp.float32) + b.astype(jnp.float32)
    return y.astype(x.dtype)


def causal_conv(u, buf, w, b):
    T = u.shape[1]
    full = jnp.concatenate([buf.astype(u.dtype), u], axis=1)
    y = b + sum(full[:, k:k + T] * w[k] for k in range(CONV_W))
    return y, full[:, -(CONV_W - 1):]


def _lin_op(l, r):
    a1, b1 = l
    a2, b2 = r
    return a1 * a2, a2 * b1 + b2


def _clin_op(l, r):
    a1r, a1i, b1r, b1i = l
    a2r, a2i, b2r, b2i = r
    return (a2r * a1r - a2i * a1i, a2r * a1i + a2i * a1r,
            a2r * b1r - a2i * b1i + b2r, a2r * b1i + a2i * b1r + b2i)


def rg_lru(v, h0, w_gates, b_gates, lam):
    Bn, T, _ = v.shape
    vb = v.reshape(Bn, T, LRU_HEADS, LRU_BLOCK)
    g = jnp.einsum('bthi,ghij->gbthj', vb, w_gates).reshape(2, Bn, T, D_RNN)
    gates = jax.nn.sigmoid(g.astype(jnp.float32) + b_gates.astype(jnp.float32)[:, None, None, :])
    r, i = gates[0], gates[1]
    log_a = -LRU_C * r * jax.nn.softplus(-lam.astype(jnp.float32))
    a = jnp.exp(log_a)
    bterm = jnp.sqrt(-jnp.expm1(2.0 * log_a)) * (i * v.astype(jnp.float32))
    bterm = bterm.at[:, 0].add(a[:, 0] * h0.astype(jnp.float32))
    _, h = lax.associative_scan(_lin_op, (a, bterm), axis=1)
    return h, h[:, -1]


def s5_discretise(a_re, a_im, log_dt, b_re, b_im):
    a_re = a_re.astype(jnp.float32)
    a_im = a_im.astype(jnp.float32)
    b_re = b_re.astype(jnp.float32)
    b_im = b_im.astype(jnp.float32)
    dt = jnp.exp(log_dt.astype(jnp.float32))[:, None]
    mag = jnp.exp(a_re * dt)
    abar_re, abar_im = mag * jnp.cos(a_im * dt), mag * jnp.sin(a_im * dt)
    nr, ni = abar_re - 1.0, abar_im
    den = a_re * a_re + a_im * a_im
    fr = (nr * a_re + ni * a_im) / den
    fi = (ni * a_re - nr * a_im) / den
    bb_re = fr[..., None] * b_re - fi[..., None] * b_im
    bb_im = fr[..., None] * b_im + fi[..., None] * b_re
    return abar_re, abar_im, bb_re, bb_im


def s5_scan(u, h0_re, h0_im, a_re, a_im, bb_re, bb_im, c_re, c_im):
    Bn, T, G, Q = u.shape
    L = math.gcd(T, S5_CHUNK)
    n = T // L
    uc = u.reshape(Bn, n, L, G, Q).swapaxes(0, 1)
    c_re = c_re.astype(jnp.float32)
    c_im = c_im.astype(jnp.float32)

    def body(carry, u_blk):
        hr, hi = carry
        br = jnp.einsum('blgq,gpq->blgp', u_blk, bb_re)
        bi = jnp.einsum('blgq,gpq->blgp', u_blk, bb_im)
        br = br.at[:, 0].add(a_re * hr - a_im * hi)
        bi = bi.at[:, 0].add(a_re * hi + a_im * hr)
        ar = jnp.broadcast_to(a_re, br.shape)
        ai = jnp.broadcast_to(a_im, bi.shape)
        _, _, xr, xi = lax.associative_scan(_clin_op, (ar, ai, br, bi), axis=1)
        y = jnp.einsum('blgp,gqp->blgq', xr, c_re) - jnp.einsum('blgp,gqp->blgq', xi, c_im)
        return (xr[:, -1], xi[:, -1]), y

    (hr, hi), ys = lax.scan(body, (h0_re.astype(jnp.float32), h0_im.astype(jnp.float32)), uc)
    return ys.swapaxes(0, 1).reshape(Bn, T, G, Q), hr, hi


def _layer(x, c, h0, conv0, sr0, si0, w_ada, b_ada, w_in, b_in, w_conv, b_conv,
           w_lru_gates, b_lru_gates, lru_lambda, w_lru_out, s5_a_re, s5_a_im, s5_log_dt,
           s5_b_re, s5_b_im, s5_c_re, s5_c_im, s5_d, w_s5_glu, w_out, ln1_g, ln1_b,
           w_ffn_up, w_ffn_down, ln2_g, ln2_b):
    dt = x.dtype
    Bn, T, _ = x.shape
    ada = (jax.nn.silu(c) @ w_ada + b_ada).reshape(Bn, N_ADA, D_MODEL)[:, :, None, :]
    sh1, sc1, g1, sh2, sc2, g2 = (ada[:, k] for k in range(N_ADA))
    u = x * (1 + sc1) + sh1
    z = u @ w_in + b_in
    z_lru, z_gate, z_s5, m_a, m_b = jnp.split(z, SPLITS, axis=-1)
    v, conv_new = causal_conv(z_lru, conv0, w_conv, b_conv)
    h, h_last = rg_lru(v, h0, w_lru_gates, b_lru_gates, lru_lambda)
    br_a = (h.astype(dt) * jax.nn.gelu(z_gate)) @ w_lru_out
    abr, abi, bbr, bbi = s5_discretise(s5_a_re, s5_a_im, s5_log_dt, s5_b_re, s5_b_im)
    us = z_s5.astype(jnp.float32).reshape(Bn, T, S5_GROUPS, S5_GROUP)
    ys, sr, si = s5_scan(us, sr0, si0, abr, abi, bbr, bbi, s5_c_re, s5_c_im)
    ys = ys.reshape(Bn, T, D_S5) + s5_d.astype(jnp.float32) * z_s5.astype(jnp.float32)
    gl = jax.nn.gelu(ys.astype(dt)) @ w_s5_glu
    br_b = gl[..., :D_MODEL] * jax.nn.sigmoid(gl[..., D_MODEL:])
    mixed = (jax.nn.sigmoid(m_a) * br_a + jax.nn.sigmoid(m_b) * br_b) @ w_out
    x = layer_norm(DN_ALPHA * x + g1 * mixed, ln1_g, ln1_b)
    u2 = x * (1 + sc2) + sh2
    hf = u2 @ w_ffn_up
    f = (jax.nn.silu(hf[..., :D_FF]) * hf[..., D_FF:]) @ w_ffn_down
    x = layer_norm(DN_ALPHA * x + g2 * f, ln2_g, ln2_b)
    return x, h_last.astype(dt), conv_new.astype(dt), sr.astype(dt), si.astype(dt)


def setup_inputs(seed: int = 0) -> dict:
    key = jax.random.key(seed)
    ks = iter(jax.random.split(key, 48))
    nrm = lambda shape, s: jax.random.normal(next(ks), shape, jnp.float32) * s
    d = {}
    d['x_prompt'] = nrm((BATCH, SEQ, D_MODEL), 1.0)
    d['x_sample'] = nrm((DEC_BATCH, DEC_SEQ, D_MODEL), 1.0)
    d['c_prompt'] = nrm((BATCH, D_MODEL), 1.0)
    d['c_sample'] = nrm((DEC_BATCH, D_MODEL), 1.0)
    d['state_lru_h'] = nrm((DEPTH, DEC_BATCH, D_RNN), 0.5)
    d['state_lru_conv'] = nrm((DEPTH, DEC_BATCH, CONV_W - 1, D_RNN), 1.0)
    d['state_s5_re'] = nrm((DEPTH, DEC_BATCH, S5_GROUPS, S5_STATE), 0.1)
    d['state_s5_im'] = nrm((DEPTH, DEC_BATCH, S5_GROUPS, S5_STATE), 0.1)
    d['w_ada'] = nrm((DEPTH, D_MODEL, N_ADA * D_MODEL), D_MODEL ** -0.5)
    d['b_ada'] = nrm((DEPTH, N_ADA * D_MODEL), 0.01)
    d['w_in'] = nrm((DEPTH, D_MODEL, N_IN), D_MODEL ** -0.5)
    d['b_in'] = nrm((DEPTH, N_IN), 0.01)
    d['w_conv'] = nrm((DEPTH, CONV_W, D_RNN), CONV_W ** -0.5)
    d['b_conv'] = nrm((DEPTH, D_RNN), 0.01)
    d['w_lru_gates'] = nrm((DEPTH, 2, LRU_HEADS, LRU_BLOCK, LRU_BLOCK), LRU_BLOCK ** -0.5)
    d['b_lru_gates'] = nrm((DEPTH, 2, D_RNN), 0.01)
    a_pow = jax.random.uniform(next(ks), (DEPTH, D_RNN), jnp.float32, 0.9, 0.999)
    s = a_pow ** (1.0 / LRU_C)
    d['lru_lambda'] = jnp.log(s) - jnp.log1p(-s)
    d['w_lru_out'] = nrm((DEPTH, D_RNN, D_MODEL), D_RNN ** -0.5)
    d['s5_a_re'] = -0.5 + nrm((DEPTH, S5_GROUPS, S5_STATE), 0.01)
    d['s5_a_im'] = jnp.pi * jnp.arange(S5_STATE, dtype=jnp.float32) + nrm((DEPTH, S5_GROUPS, S5_STATE), 0.01)
    d['s5_log_dt'] = jax.random.uniform(next(ks), (DEPTH, S5_GROUPS), jnp.float32, math.log(0.001), math.log(0.1))
    d['s5_b_re'] = nrm((DEPTH, S5_GROUPS, S5_STATE, S5_GROUP), (2 * S5_GROUP) ** -0.5)
    d['s5_b_im'] = nrm((DEPTH, S5_GROUPS, S5_STATE, S5_GROUP), (2 * S5_GROUP) ** -0.5)
    d['s5_c_re'] = nrm((DEPTH, S5_GROUPS, S5_GROUP, S5_STATE), (2 * S5_STATE) ** -0.5)
    d['s5_c_im'] = nrm((DEPTH, S5_GROUPS, S5_GROUP, S5_STATE), (2 * S5_STATE) ** -0.5)
    d['s5_d'] = nrm((DEPTH, D_S5), 1.0)
    d['w_s5_glu'] = nrm((DEPTH, D_S5, 2 * D_MODEL), D_S5 ** -0.5)
    d['w_out'] = nrm((DEPTH, D_MODEL, D_MODEL), D_MODEL ** -0.5 * DN_BETA)
    d['ln1_g'] = 1.0 + nrm((DEPTH, D_MODEL), 0.02)
    d['ln1_b'] = nrm((DEPTH, D_MODEL), 0.01)
    d['w_ffn_up'] = nrm((DEPTH, D_MODEL, 2 * D_FF), D_MODEL ** -0.5)
    d['w_ffn_down'] = nrm((DEPTH, D_FF, D_MODEL), D_FF ** -0.5 * DN_BETA)
    d['ln2_g'] = 1.0 + nrm((DEPTH, D_MODEL), 0.02)
    d['ln2_b'] = nrm((DEPTH, D_MODEL), 0.01)
    return d


def reference(x_prompt, x_sample, c_prompt, c_sample, state_lru_h, state_lru_conv, state_s5_re,
              state_s5_im, w_ada, b_ada, w_in, b_in, w_conv, b_conv, w_lru_gates, b_lru_gates,
              lru_lambda, w_lru_out, s5_a_re, s5_a_im, s5_log_dt, s5_b_re, s5_b_im, s5_c_re,
              s5_c_im, s5_d, w_s5_glu, w_out, ln1_g, ln1_b, w_ffn_up, w_ffn_down, ln2_g, ln2_b):
    dt = x_prompt.dtype
    Bp = x_prompt.shape[0]
    hp0 = jnp.zeros((Bp, D_RNN), dt)
    cp0 = jnp.zeros((Bp, CONV_W - 1, D_RNN), dt)
    sp0 = jnp.zeros((Bp, S5_GROUPS, S5_STATE), dt)
    yp, ys = x_prompt, x_sample
    hp, hs, cvp, cvs, srp, srs, sip, sis = [], [], [], [], [], [], [], []
    for l in range(DEPTH):
        lw = (w_ada[l], b_ada[l], w_in[l], b_in[l], w_conv[l], b_conv[l], w_lru_gates[l],
              b_lru_gates[l], lru_lambda[l], w_lru_out[l], s5_a_re[l], s5_a_im[l], s5_log_dt[l],
              s5_b_re[l], s5_b_im[l], s5_c_re[l], s5_c_im[l], s5_d[l], w_s5_glu[l], w_out[l],
              ln1_g[l], ln1_b[l], w_ffn_up[l], w_ffn_down[l], ln2_g[l], ln2_b[l])
        yp, h1, c1, r1, i1 = _layer(yp, c_prompt, hp0, cp0, sp0, sp0, *lw)
        ys, h2, c2, r2, i2 = _layer(ys, c_sample, state_lru_h[l], state_lru_conv[l],
                                    state_s5_re[l], state_s5_im[l], *lw)
        hp.append(h1); hs.append(h2); cvp.append(c1); cvs.append(c2)
        srp.append(r1); srs.append(r2); sip.append(i1); sis.append(i2)
    return (yp, ys, jnp.stack(hp), jnp.stack(hs), jnp.stack(cvp), jnp.stack(cvs),
            jnp.stack(srp), jnp.stack(srs), jnp.stack(sip), jnp.stack(sis))
```

```cpp
#include <hip/hip_runtime.h>
#include <cstdio>
#include <cstdint>

#define LAS __attribute__((address_space(3)))
#define GAS __attribute__((address_space(1)))
typedef unsigned short bf16;
typedef short bf16x8 __attribute__((ext_vector_type(8)));
typedef float f32x4 __attribute__((ext_vector_type(4)));
typedef float f32x2 __attribute__((ext_vector_type(2)));
typedef unsigned u32x4 __attribute__((ext_vector_type(4)));
typedef unsigned u32x2 __attribute__((ext_vector_type(2)));

#ifndef MK_ONE_LAUNCH
#define MK_ONE_LAUNCH 1
#endif
#ifndef PH_MASK
#define PH_MASK 0xFFF
#endif
#define PH_ON(k) (((PH_MASK) >> (k)) & 1)

constexpr int D = 1024, MP = 16384, MS = 512, M = MP + MS, TSEQ = 2048, NSEQ = 136;
constexpr int NIN = 5120, DFF = 2816, NADA = 6144;
constexpr float DN_ALPHA = 1.4142135623730951f, LN_EPS = 1e-5f;
constexpr int NWAVES = 8;

constexpr size_t MiB = 1u << 20;
constexpr size_t WS_CTL = 0, CTL_ZERO_BYTES = 64 * 1024;
constexpr size_t WS_ADA = 1 * MiB;
constexpr size_t WS_WIN = 8 * MiB;
constexpr size_t WS_W2 = 18 * MiB;
constexpr size_t WS_WOUT2 = 24 * MiB;
constexpr size_t WS_TW = 28 * MiB;
constexpr size_t WS_WST = 40 * MiB;
constexpr size_t WS_S5AUX = 48 * MiB;
constexpr size_t WS_SC = 49 * MiB;
constexpr size_t WS_ZS5S = 50 * MiB;
constexpr size_t U1 = (size_t)M * D * 2;
constexpr size_t WS_T1 = 52 * MiB, WS_T2 = WS_T1 + U1, WS_T3 = WS_T2 + U1, WS_T4 = WS_T3 + U1;
constexpr size_t WS_T5 = WS_T4 + 48 * MiB;
constexpr size_t WS_END = WS_T5 + 2 * U1;
constexpr size_t WS_HF = WS_T4;
constexpr size_t WS_WUP = 242 * MiB;
constexpr size_t WS_WDN = 253 * MiB;
constexpr size_t WS_WADA = WS_T5;
static_assert(WS_HF + (size_t)M * DFF * 2 <= WS_WUP && WS_WDN + (size_t)D * DFF * 2 <= WS_END, "ws map");
static_assert(WS_END <= 280789504ull, "ws map exceeds the guaranteed workspace");
constexpr size_t O_Y = 0, O_HP = 17301504, O_HS = 17317888, O_CP = 17580032, O_CS = 17629184, O_RP = 18415616, O_RS = 18481152, O_IP = 19529728, O_IS = 19595264;

constexpr int RING_BYTES = 131072, MISC_OFF = RING_BYTES + 320, LDS_BYTES = 147456;

__device__ __forceinline__ unsigned cvt_pk_bf16(float lo, float hi) { unsigned r; asm volatile("v_cvt_pk_bf16_f32 %0, %1, %2" : "=v"(r) : "v"(lo), "v"(hi)); return r; }
__device__ __forceinline__ float bf_lo(unsigned w) { return __uint_as_float(w << 16); }
__device__ __forceinline__ float bf_hi(unsigned w) { return __uint_as_float(w & 0xffff0000u); }
__device__ __forceinline__ float bf2f(bf16 b) { return __uint_as_float(((unsigned)b) << 16); }
__device__ __forceinline__ bf16 f2bf(float f) { return (bf16)(cvt_pk_bf16(f, 0.f) & 0xffffu); }
__device__ __forceinline__ float sigm(float x) { return __builtin_amdgcn_rcpf(1.f + __expf(-x)); }
__device__ __forceinline__ float gelu_t(float x) { return x * sigm(x * (1.5957691216f + 0.0713548163f * x * x)); }
__device__ __forceinline__ float silu_f(float x) { return x * sigm(x); }
__device__ __forceinline__ int seq_of_row(int row) { return row < MP ? (row >> 11) : 8 + ((row - MP) >> 2); }
__device__ __forceinline__ float wave_sum(float v, int lane) {
#pragma unroll
    for (int o = 1; o < 64; o <<= 1) v += __int_as_float(__builtin_amdgcn_ds_bpermute((lane ^ o) << 2, __float_as_int(v)));
    return v;
}
#define LDS_WAIT() asm volatile("s_waitcnt lgkmcnt(0)" ::: "memory")
#define VM_WAIT() asm volatile("s_waitcnt vmcnt(0)" ::: "memory")

namespace pg8 {
constexpr int BM = 256, BK = 64, HALF = 128, HTB = HALF * BK * 2, STAGE_BYTES = 8 * HTB, NXCD = 8, WGM = 8;
__host__ __device__ __forceinline__ int lds_byte(int r, int c) { const int st = (r >> 4) * 2 + (c >> 5), rr = r & 15, cc = c & 31, ob = rr * 64 + cc * 2; return st * 1024 + (ob ^ (((ob >> 9) & 1) << 5)); }
__host__ __device__ __forceinline__ void stage_rc(int b, int& R, int& C) { const int st = b / 1024, sb = b % 1024, swz = sb ^ (((sb >> 9) & 1) << 5); R = (st >> 1) * 16 + swz / 64; C = (st & 1) * 32 + (swz % 64) / 2; }
__host__ __device__ __forceinline__ int perm32(int rho) { const int n = rho >> 4, i = rho & 15; return 8 * (i >> 2) + 4 * n + (i & 3); }

struct Unit { int pm, pn; };
struct Gemm { int lda, ldb, K; };

struct StaticOrder {
    int nM, nN, nwg, G, c;
    __device__ void init(int nM_, int nN_, int G_, int c_) { nM = nM_; nN = nN_; nwg = nM * nN; G = G_; c = c_; }
    __device__ bool next(int i, Unit& u) const {
        const long L = (long)i * G + c; if (L >= nwg) return false;
        int wgid = (int)L; { const int q = nwg / NXCD, r = nwg % NXCD, xcd = wgid % NXCD, off = wgid / NXCD; wgid = (xcd < r ? xcd * (q + 1) : r * (q + 1) + (xcd - r) * q) + off; }
        const int nig = WGM * nN, gid = wgid / nig, fm = gid * WGM, gsz = (nM - fm) < WGM ? (nM - fm) : WGM;
        u.pm = fm + ((wgid % nig) % gsz); u.pn = (wgid % nig) / gsz; return true;
    }
};
struct SchedStd {
    StaticOrder o; const char* A0; const char* A1; int asplit; size_t at, bt; const char* B0;
    __device__ __forceinline__ bool next(int i, Unit& u) const { return o.next(i, u); }
    __device__ __forceinline__ const char* A(const Unit& u) const { return (u.pn < asplit ? A0 : A1) + (size_t)u.pm * at; }
    __device__ __forceinline__ const char* B(const Unit& u) const { return B0 + (size_t)u.pn * bt; }
};
struct SchedS5 {
    int u0, n; const char* A0; const char* B0; size_t at, bt;
    __device__ __forceinline__ bool next(int i, Unit& u) const { if (i >= n) return false; u.pm = u0 + i; u.pn = (u0 + i) >> 2; return true; }
    __device__ __forceinline__ const char* A(const Unit& u) const { return A0 + (size_t)u.pm * at; }
    __device__ __forceinline__ const char* B(const Unit& u) const { return B0 + (size_t)u.pn * bt; }
};

template <class Epi, class Sched, bool ALIGN_EPI, bool SP2>
__device__ __forceinline__ void gemm_phase(LAS unsigned char* lds, const Gemm g, const Sched& S, const Epi& E, const int tid_in) {
    int tid = tid_in; asm volatile("" : "+v"(tid));
    const int wid = __builtin_amdgcn_readfirstlane(tid >> 6), lane = tid & 63, wr = wid >> 2, wc = wid & 3, fr = lane & 15, fq = lane >> 4;
    const int nt = g.K / BK;
    unsigned voffA[2], voffB[2];
#pragma unroll
    for (int i = 0; i < 2; ++i) { int R, C; stage_rc(tid * 16 + i * 8192, R, C); const int Rb = Epi::PERM ? ((R & ~31) + perm32(R & 31)) : R;
        voffA[i] = (unsigned)(R * g.lda + C) * 2u; voffB[i] = (unsigned)(Rb * g.ldb + C) * 2u; }
    const size_t kstep = (size_t)(BK * 2);
    const size_t hA = (size_t)HALF * g.lda * 2, hB = (size_t)HALF * g.ldb * 2;
    const unsigned ldsw = (unsigned)wid * 1024u;
    const int aoff = lds_byte(wr * 64 + fr, fq * 8), boff = lds_byte(wc * 32 + fr, fq * 8);
#define PG8_SA(b, h) (((b) * 2 + (h)) * HTB)
#define PG8_SB(b, h) ((4 + (b) * 2 + (h)) * HTB)
#define PG8_STAGE(bufoff, gbase, voff) do { _Pragma("unroll") for (int _i = 0; _i < 2; ++_i) \
        __builtin_amdgcn_global_load_lds((const unsigned*)((const char*)(gbase) + (voff)[_i]), (LAS unsigned*)(lds + (bufoff) + ldsw + _i * 8192), 16, 0, 0); } while (0)
#define PG8_LDA(dst, b, h) do { _Pragma("unroll") for (int m = 0; m < 4; ++m) _Pragma("unroll") for (int k = 0; k < 2; ++k) dst[m][k] = *(const LAS bf16x8*)(lds + PG8_SA(b, h) + aoff + m * 2048 + k * 1024); } while (0)
#define PG8_LDB(dst, b, h) do { _Pragma("unroll") for (int n = 0; n < 2; ++n) _Pragma("unroll") for (int k = 0; k < 2; ++k) dst[n][k] = *(const LAS bf16x8*)(lds + PG8_SB(b, h) + boff + n * 2048 + k * 1024); } while (0)
#define PG8_MMA(ai, bj, At, Bt) do { __builtin_amdgcn_s_setprio(1); _Pragma("unroll") for (int m = 0; m < 4; ++m) _Pragma("unroll") for (int n = 0; n < 2; ++n) _Pragma("unroll") for (int k = 0; k < 2; ++k) \
        acc[ai][bj][m][n] = __builtin_amdgcn_mfma_f32_16x16x32_bf16(Bt[n][k], At[m][k], acc[ai][bj][m][n], 0, 0, 0); __builtin_amdgcn_s_setprio(0); } while (0)
#define PG8_WAIT_V(n) asm volatile("s_waitcnt vmcnt(" #n ")" ::: "memory")
#define PG8_WAIT_L(n) asm volatile("s_waitcnt lgkmcnt(" #n ")" ::: "memory")
#define PG8_BAR __builtin_amdgcn_s_barrier()
#define PG8_SCHED __builtin_amdgcn_sched_barrier(0)
    Unit cur, nxt; int ui = 0;
    if (!S.next(0, cur)) return;
    f32x4 acc[2][2][4][2];
#pragma unroll
    for (int a = 0; a < 2; ++a)
#pragma unroll
        for (int b = 0; b < 2; ++b)
#pragma unroll
            for (int m = 0; m < 4; ++m)
#pragma unroll
                for (int n = 0; n < 2; ++n) acc[a][b][m][n] = (f32x4){0.f, 0.f, 0.f, 0.f};
    bf16x8 At[4][2], B0[2][2], B1[2][2];
    const char* cA = S.A(cur); const char* cB = S.B(cur);
    if constexpr (SP2) {
        PG8_STAGE(PG8_SB(0, 0), cB, voffB); PG8_STAGE(PG8_SB(0, 1), cB + hB, voffB); PG8_STAGE(PG8_SA(0, 0), cA, voffA); PG8_STAGE(PG8_SA(0, 1), cA + hA, voffA);
        if (wr == 1) PG8_BAR;
        PG8_WAIT_V(2); PG8_BAR;
        PG8_STAGE(PG8_SB(1, 0), cB + kstep, voffB); PG8_STAGE(PG8_SA(1, 0), cA + kstep, voffA); PG8_STAGE(PG8_SB(1, 1), cB + hB + kstep, voffB);
        PG8_WAIT_V(6); PG8_BAR;
    } else {
        PG8_STAGE(PG8_SB(0, 0), cB, voffB); PG8_STAGE(PG8_SA(0, 0), cA, voffA); PG8_STAGE(PG8_SB(0, 1), cB + hB, voffB); PG8_STAGE(PG8_SA(0, 1), cA + hA, voffA);
        if (wr == 1) PG8_BAR;
        PG8_WAIT_V(4); PG8_BAR;
        PG8_STAGE(PG8_SB(1, 0), cB + kstep, voffB); PG8_STAGE(PG8_SA(1, 0), cA + kstep, voffA); PG8_STAGE(PG8_SB(1, 1), cB + hB + kstep, voffB);
        PG8_WAIT_V(6); PG8_BAR;
    }
    for (;;) {
        const bool has_next = S.next(ui + 1, nxt);
        const char* nA = has_next ? S.A(nxt) : cA; const char* nB = has_next ? S.B(nxt) : cB;
#pragma unroll 1
        for (int t = 0; t < nt; t += 2) {
            const bool last = (t == nt - 2);
            const char* a1 = cA + (size_t)(t + 1) * kstep;
            const char* a2 = last ? nA : cA + (size_t)(t + 2) * kstep; const char* b2 = last ? nB : cB + (size_t)(t + 2) * kstep;
            const char* a3 = a2 + kstep; const char* b3 = b2 + kstep;
            if constexpr (SP2) {
            PG8_LDB(B0, 0, 0); PG8_LDB(B1, 0, 1); PG8_SCHED; PG8_LDA(At, 0, 0); PG8_STAGE(PG8_SA(1, 1), a1 + hA, voffA);
            PG8_WAIT_V(8); PG8_WAIT_L(0); PG8_BAR; PG8_MMA(0, 0, At, B0); PG8_MMA(0, 1, At, B1); PG8_BAR; PG8_SCHED;
            PG8_LDA(At, 0, 1); PG8_STAGE(PG8_SB(0, 0), b2, voffB); PG8_STAGE(PG8_SB(0, 1), b2 + hB, voffB); PG8_STAGE(PG8_SA(0, 0), a2, voffA);
            PG8_WAIT_V(8); PG8_WAIT_L(0); PG8_BAR; PG8_MMA(1, 0, At, B0); PG8_MMA(1, 1, At, B1); PG8_BAR; PG8_SCHED;
            PG8_LDB(B0, 1, 0); PG8_LDB(B1, 1, 1); PG8_SCHED; PG8_LDA(At, 1, 0); PG8_STAGE(PG8_SA(0, 1), a2 + hA, voffA);
            PG8_WAIT_V(8); PG8_WAIT_L(0); PG8_BAR; PG8_MMA(0, 0, At, B0); PG8_MMA(0, 1, At, B1); PG8_BAR; PG8_SCHED;
            PG8_LDA(At, 1, 1); PG8_STAGE(PG8_SB(1, 0), b3, voffB); PG8_STAGE(PG8_SB(1, 1), b3 + hB, voffB); PG8_STAGE(PG8_SA(1, 0), a3, voffA);
            PG8_WAIT_V(8); PG8_WAIT_L(0); PG8_BAR; PG8_MMA(1, 0, At, B0); PG8_MMA(1, 1, At, B1); PG8_BAR; PG8_SCHED;
            } else {
            PG8_LDB(B0, 0, 0); PG8_SCHED; PG8_LDA(At, 0, 0); PG8_STAGE(PG8_SA(1, 1), a1 + hA, voffA);
            PG8_WAIT_L(8); PG8_BAR; PG8_WAIT_L(0); PG8_MMA(0, 0, At, B0); PG8_BAR; PG8_SCHED;
            PG8_LDB(B1, 0, 1); PG8_STAGE(PG8_SB(0, 0), b2, voffB);
            PG8_BAR; PG8_WAIT_L(0); PG8_MMA(0, 1, At, B1); PG8_BAR;
            PG8_LDA(At, 0, 1); PG8_STAGE(PG8_SA(0, 0), a2, voffA);
            PG8_BAR; PG8_WAIT_L(0); PG8_MMA(1, 0, At, B0); PG8_BAR; PG8_SCHED;
            PG8_STAGE(PG8_SB(0, 1), b2 + hB, voffB);
            PG8_WAIT_V(6); PG8_BAR; PG8_MMA(1, 1, At, B1); PG8_BAR;
            PG8_LDB(B0, 1, 0); PG8_SCHED; PG8_LDA(At, 1, 0); PG8_STAGE(PG8_SA(0, 1), a2 + hA, voffA);
            PG8_WAIT_L(8); PG8_BAR; PG8_WAIT_L(0); PG8_MMA(0, 0, At, B0); PG8_BAR; PG8_SCHED;
            PG8_LDB(B1, 1, 1); PG8_STAGE(PG8_SB(1, 0), b3, voffB);
            PG8_BAR; PG8_WAIT_L(0); PG8_MMA(0, 1, At, B1); PG8_BAR;
            PG8_LDA(At, 1, 1); PG8_STAGE(PG8_SA(1, 0), a3, voffA);
            PG8_BAR; PG8_WAIT_L(0); PG8_MMA(1, 0, At, B0); PG8_BAR; PG8_SCHED;
            PG8_STAGE(PG8_SB(1, 1), b3 + hB, voffB);
            PG8_WAIT_V(6); PG8_BAR; PG8_MMA(1, 1, At, B1); PG8_BAR;
            }
        }
        if constexpr (ALIGN_EPI) { if (wr == 0) PG8_BAR; }
        if constexpr (!Epi::AFTER_DRAIN) { E(acc, cur, wr, wc, fr, fq); }
        if (!has_next) break;
#pragma unroll
        for (int a = 0; a < 2; ++a)
#pragma unroll
            for (int b = 0; b < 2; ++b)
#pragma unroll
                for (int m = 0; m < 4; ++m)
#pragma unroll
                    for (int n = 0; n < 2; ++n) acc[a][b][m][n] = (f32x4){0.f, 0.f, 0.f, 0.f};
        cur = nxt; cA = nA; cB = nB; ++ui;
        if constexpr (ALIGN_EPI) { if (wr == 1) PG8_BAR; }
    }
    PG8_WAIT_V(0);
    if constexpr (!ALIGN_EPI) { if (wr == 0) PG8_BAR; }
    PG8_BAR;
    if constexpr (Epi::AFTER_DRAIN) { E.fused(acc, cur, wr, wc, fr, fq, lds, wid, lane); }
#undef PG8_SA
#undef PG8_SB
#undef PG8_STAGE
#undef PG8_LDA
#undef PG8_LDB
#undef PG8_MMA
#undef PG8_WAIT_V
#undef PG8_WAIT_L
#undef PG8_BAR
#undef PG8_SCHED
}
}
typedef const f32x4 (&AccRef)[2][2][4][2];

__device__ __forceinline__ u32x4 pack8(f32x4 v0, f32x4 v1) { u32x4 w; w.x = cvt_pk_bf16(v0[0], v0[1]); w.y = cvt_pk_bf16(v0[2], v0[3]); w.z = cvt_pk_bf16(v1[0], v1[1]); w.w = cvt_pk_bf16(v1[2], v1[3]); return w; }

struct EpiAda {
    static constexpr bool PERM = false, AFTER_DRAIN = false;
    float* ada; const float* bias;
    __device__ __forceinline__ void operator()(AccRef acc, const pg8::Unit& u, int wr, int wc, int fr, int fq) const {
        const int col0 = u.pn * 256 + wc * 32 + 4 * fq;
#pragma unroll
        for (int ai = 0; ai < 2; ++ai)
#pragma unroll
            for (int m = 0; m < 4; ++m) { const int row = ai * 128 + wr * 64 + m * 16 + fr;
                if (row < NSEQ) {
#pragma unroll
                    for (int bj = 0; bj < 2; ++bj)
#pragma unroll
                        for (int n = 0; n < 2; ++n) { const int c = col0 + bj * 128 + n * 16; *(f32x4*)(ada + (size_t)row * 12288 + c) = acc[ai][bj][m][n] + *(const f32x4*)(bias + c); } } }
    }
};
struct EpiG1 {
    static constexpr bool PERM = true, AFTER_DRAIN = false;
    bf16 *zl, *zg, *zs, *zs5s, *mab; const float* bias;
    __device__ __forceinline__ void operator()(AccRef acc, const pg8::Unit& u, int wr, int wc, int fr, int fq) const {
        const int pn = u.pn, cb = wc * 32 + 8 * fq;
        f32x4 bv[2][2];
#pragma unroll
        for (int bj = 0; bj < 2; ++bj)
#pragma unroll
            for (int n = 0; n < 2; ++n) bv[bj][n] = *(const f32x4*)(bias + pn * 256 + bj * 128 + cb + 4 * n);
#pragma unroll
        for (int ai = 0; ai < 2; ++ai)
#pragma unroll
            for (int m = 0; m < 4; ++m) { const int row = u.pm * 256 + ai * 128 + wr * 64 + m * 16 + fr;
#pragma unroll
                for (int bj = 0; bj < 2; ++bj) {
                    const u32x4 w = pack8(acc[ai][bj][m][0] + bv[bj][0], acc[ai][bj][m][1] + bv[bj][1]);
                    const int col = pn * 256 + bj * 128 + cb;
                    bf16* dst;
                    if (pn < 4) dst = zl + (size_t)row * D + col;
                    else if (pn < 8) dst = zg + (size_t)row * D + (col - 1024);
                    else if (pn < 12) { const int j = col - 2048;
                        if (row < MP) dst = zs + ((size_t)(j >> 4) * 1024 + (row >> 4)) * 384 + (row & 15) * 16 + (j & 15);
                        else dst = zs5s + (size_t)(row - MP) * D + j; }
                    else dst = mab + (size_t)row * 2048 + (col - 3072);
                    *(u32x4*)dst = w; }
                asm volatile("" ::: "memory"); }
    }
};
struct EpiS5A {
    static constexpr bool PERM = false, AFTER_DRAIN = true;
    bf16* zs; const float* a16re; const float* a16im; float* ore; float* oim;
    __device__ __forceinline__ void fused(AccRef acc, const pg8::Unit& u, int wr, int wc, int fr, int fq, LAS unsigned char* lds, int wid, int lane) const {
        LAS f32x4* S4 = (LAS f32x4*)lds;
#pragma unroll
        for (int ai = 0; ai < 2; ++ai)
#pragma unroll
            for (int m = 0; m < 4; ++m) { const int row = ai * 128 + wr * 64 + m * 16 + fr;
#pragma unroll
                for (int n = 0; n < 2; ++n) { const int c4 = wc * 8 + n * 4 + fq; S4[row * 32 + (c4 ^ (row & 31))] = acc[ai][0][m][n]; } }
        LDS_WAIT(); __syncthreads();
        const int g = u.pm >> 2, mt = u.pm & 3, tid = wid * 64 + lane;
        if (tid < 128) {
            const int sg = tid >> 6, p = tid & 63;
            const float ar = a16re[g * 64 + p], ai_ = a16im[g * 64 + p];
            float hr = 0.f, hi = 0.f;
            const LAS float* Sf = (const LAS float*)lds;
            bf16* hrow = zs + ((size_t)g * 1024 + mt * 256 + sg * 128) * 384 + 256;
            for (int c = 0; c < 128; ++c) {
                const int row = sg * 128 + c;
                hrow[(size_t)c * 384 + p] = f2bf(hr); hrow[(size_t)c * 384 + 64 + p] = f2bf(hi);
                const float sr = Sf[(row * 32 + ((p >> 2) ^ (row & 31))) * 4 + (p & 3)];
                const float si = Sf[(row * 32 + (((64 + p) >> 2) ^ (row & 31))) * 4 + (p & 3)];
                const float nr = ar * hr - ai_ * hi + sr, ni = ar * hi + ai_ * hr + si;
                hr = nr; hi = ni;
            }
            const int b = mt * 2 + sg;
            ore[(b * 64 + g) * 64 + p] = hr; oim[(b * 64 + g) * 64 + p] = hi;
        }
        __syncthreads();
    }
};
struct EpiS5B {
    static constexpr bool PERM = true, AFTER_DRAIN = false;
    const bf16* zs; bf16* gy; const float* dvec;
    __device__ __forceinline__ void operator()(AccRef acc, const pg8::Unit& u, int wr, int wc, int fr, int fq) const {
        const int g = u.pm >> 2, mt = u.pm & 3, q0 = 8 * (fq & 1), t0 = 2 * wc + (fq >> 1);
        const f32x4 d0 = *(const f32x4*)(dvec + g * 16 + q0), d1 = *(const f32x4*)(dvec + g * 16 + q0 + 4);
        const int cc0 = mt * 256 + wr * 64 + fr;
        const bf16* zb = zs + ((size_t)g * 1024 + cc0) * 384 + t0 * 16 + q0;
        bf16* gb = gy + ((size_t)cc0 * 16 + t0) * D + g * 16 + q0;
#pragma unroll
        for (int ai = 0; ai < 2; ++ai)
#pragma unroll
            for (int m = 0; m < 4; ++m) {
#pragma unroll
                for (int bj = 0; bj < 2; ++bj) {
                    const bf16* zp = zb; bf16* gp = gb; asm volatile("" : "+v"(zp), "+v"(gp));
                    const int dc = ai * 128 + m * 16;
                    const u32x4 uw = *(const u32x4*)(zp + (size_t)dc * 384 + bj * 128);
                    f32x4 v0 = acc[ai][bj][m][0], v1 = acc[ai][bj][m][1];
                    v0[0] += d0[0] * bf_lo(uw.x); v0[1] += d0[1] * bf_hi(uw.x); v0[2] += d0[2] * bf_lo(uw.y); v0[3] += d0[3] * bf_hi(uw.y);
                    v1[0] += d1[0] * bf_lo(uw.z); v1[1] += d1[1] * bf_hi(uw.z); v1[2] += d1[2] * bf_lo(uw.w); v1[3] += d1[3] * bf_hi(uw.w);
#pragma unroll
                    for (int j = 0; j < 4; ++j) { v0[j] = gelu_t(v0[j]); v1[j] = gelu_t(v1[j]); }
                    *(u32x4*)(gp + ((size_t)dc * 16 + bj * 8) * D) = pack8(v0, v1); }
                asm volatile("" ::: "memory"); }
    }
};
struct EpiG2 {
    static constexpr bool PERM = true, AFTER_DRAIN = false;
    bf16* mab;
    __device__ __forceinline__ void operator()(AccRef acc, const pg8::Unit& u, int wr, int wc, int fr, int fq) const {
        const int pn = u.pn, cb = wc * 32 + 8 * fq;
#pragma unroll
        for (int ai = 0; ai < 2; ++ai)
#pragma unroll
            for (int m = 0; m < 4; ++m) { const int row = u.pm * 256 + ai * 128 + wr * 64 + m * 16 + fr;
                if (pn < 4) {
#pragma unroll
                    for (int bj = 0; bj < 2; ++bj) { bf16* p = mab + (size_t)row * 2048 + pn * 256 + bj * 128 + cb; const u32x4 mw = *(const u32x4*)p;
                        f32x4 v0 = acc[ai][bj][m][0], v1 = acc[ai][bj][m][1];
                        v0[0] *= sigm(bf_lo(mw.x)); v0[1] *= sigm(bf_hi(mw.x)); v0[2] *= sigm(bf_lo(mw.y)); v0[3] *= sigm(bf_hi(mw.y));
                        v1[0] *= sigm(bf_lo(mw.z)); v1[1] *= sigm(bf_hi(mw.z)); v1[2] *= sigm(bf_lo(mw.w)); v1[3] *= sigm(bf_hi(mw.w));
                        *(u32x4*)p = pack8(v0, v1); }
                } else {
                    bf16* p = mab + (size_t)row * 2048 + 1024 + (pn - 4) * 128 + cb; const u32x4 mw = *(const u32x4*)p;
                    f32x4 v0 = acc[ai][0][m][0], v1 = acc[ai][0][m][1]; const f32x4 g0 = acc[ai][1][m][0], g1 = acc[ai][1][m][1];
#pragma unroll
                    for (int j = 0; j < 4; ++j) { v0[j] *= sigm(g0[j]); v1[j] *= sigm(g1[j]); }
                    v0[0] *= sigm(bf_lo(mw.x)); v0[1] *= sigm(bf_hi(mw.x)); v0[2] *= sigm(bf_lo(mw.y)); v0[3] *= sigm(bf_hi(mw.y));
                    v1[0] *= sigm(bf_lo(mw.z)); v1[1] *= sigm(bf_hi(mw.z)); v1[2] *= sigm(bf_lo(mw.w)); v1[3] *= sigm(bf_hi(mw.w));
                    *(u32x4*)p = pack8(v0, v1);
                }
                asm volatile("" ::: "memory"); }
    }
};
struct EpiRes {
    static constexpr bool PERM = false, AFTER_DRAIN = false;
    const float* xp; const float* xs;
    const float* gate;
    float* pre;
    __device__ __forceinline__ void operator()(AccRef acc, const pg8::Unit& u, int wr, int wc, int fr, int fq) const {
        const int col0 = u.pn * 256 + wc * 32 + 4 * fq;
#pragma unroll
        for (int ai = 0; ai < 2; ++ai)
#pragma unroll
            for (int m = 0; m < 4; ++m) { const int row = u.pm * 256 + ai * 128 + wr * 64 + m * 16 + fr;
                const float* xr = (row < MP ? xp + (size_t)row * D : xs + (size_t)(row - MP) * D) + col0;
                const float* gr = gate + (size_t)seq_of_row(row) * 12288 + col0;
                float* pr = pre + (size_t)row * D + col0;
#pragma unroll
                for (int bj = 0; bj < 2; ++bj)
#pragma unroll
                    for (int n = 0; n < 2; ++n) { const int o = bj * 128 + n * 16; const f32x4 xv = *(const f32x4*)(xr + o), gv = *(const f32x4*)(gr + o);
                        *(f32x4*)(pr + o) = xv * DN_ALPHA + gv * acc[ai][bj][m][n]; }
                asm volatile("" ::: "memory"); }
    }
};
struct EpiG4 {
    static constexpr bool PERM = true, AFTER_DRAIN = false;
    bf16* hf;
    __device__ __forceinline__ void operator()(AccRef acc, const pg8::Unit& u, int wr, int wc, int fr, int fq) const {
        const int cb = u.pn * 128 + wc * 32 + 8 * fq;
#pragma unroll
        for (int ai = 0; ai < 2; ++ai)
#pragma unroll
            for (int m = 0; m < 4; ++m) { const int row = u.pm * 256 + ai * 128 + wr * 64 + m * 16 + fr;
                f32x4 v0 = acc[ai][0][m][0], v1 = acc[ai][0][m][1]; const f32x4 g0 = acc[ai][1][m][0], g1 = acc[ai][1][m][1];
#pragma unroll
                for (int j = 0; j < 4; ++j) { v0[j] = silu_f(v0[j]) * g0[j]; v1[j] = silu_f(v1[j]) * g1[j]; }
                *(u32x4*)(hf + (size_t)row * DFF + cb) = pack8(v0, v1);
                asm volatile("" ::: "memory"); }
    }
};

#define XB_TMO      128
#define XB_XCNT(j)  (256  + 64 * (j))
#define XB_XSUB(j)  (1280 + 64 * (j))
#define XB_XGEN(j)  (2304 + 64 * (j))
#define XB_TOP      3328
#define XB_TOPGEN   3392
#define XCD_BAR_WORDS 3456
#define XB_SPIN_CAP (1u << 20)
__device__ __forceinline__ unsigned xb_ld(unsigned* p)              { return __hip_atomic_load(p, __ATOMIC_RELAXED, __HIP_MEMORY_SCOPE_AGENT); }
__device__ __forceinline__ unsigned xb_add(unsigned* p, unsigned v) { return __hip_atomic_fetch_add(p, v, __ATOMIC_RELAXED, __HIP_MEMORY_SCOPE_AGENT); }
__device__ __forceinline__ unsigned xb_xcc_id() { return (unsigned)__builtin_amdgcn_s_getreg((3 << 11) | 20) & 0xFu; }
#define XB_SPIN(cond, bar) do { unsigned _sp = 0; while (cond) { __builtin_amdgcn_s_sleep(1); \
    if ((++_sp & 255u) == 0u) { if (xb_ld(&(bar)[XB_TMO])) break; if (_sp > XB_SPIN_CAP) { atomicAdd(&(bar)[XB_TMO], 1u); break; } } } } while (0)
struct XcdBarrier { unsigned* bar; unsigned x; volatile LAS unsigned* st; };
__device__ __forceinline__ XcdBarrier xcd_barrier_post(unsigned* bar, volatile LAS unsigned* st) {
    XcdBarrier b; b.bar = bar; b.x = xb_xcc_id(); b.st = st;
    if (threadIdx.x == 0) (void)xb_add(&bar[XB_XCNT(b.x)], 1u);
    return b;
}
__device__ __forceinline__ void xcd_barrier_complete(unsigned* bar, unsigned x, unsigned& nloc, unsigned& nx) {
    const unsigned G = gridDim.x * gridDim.y * gridDim.z;
    unsigned sum, cnt, mine, sp = 0u;
    for (;;) {
        sum = 0u; cnt = 0u; mine = 0u;
#pragma unroll
        for (unsigned j = 0; j < 16; ++j) { const unsigned c = xb_ld(&bar[XB_XCNT(j)]); sum += c; cnt += (c > 0u) ? 1u : 0u; mine = (j == x) ? c : mine; }
        if (sum == G) break;
        __builtin_amdgcn_s_sleep(1);
        if ((++sp & 255u) == 0u) { if (xb_ld(&bar[XB_TMO])) break; if (sp > XB_SPIN_CAP) { atomicAdd(&bar[XB_TMO], 1u); break; } }
    }
    nloc = mine > 0u ? mine : 1u; nx = cnt > 0u ? cnt : 1u;
}
__device__ __forceinline__ void xcd_barrier(const XcdBarrier& b) {
    asm volatile("s_waitcnt vmcnt(0)" ::: "memory");
    __syncthreads();
    if (threadIdx.x == 0) {
        unsigned* bar = b.bar;
        __builtin_amdgcn_s_waitcnt(0);
        unsigned nloc = b.st[0], nx = b.st[1];
        if (nloc == 0u) { xcd_barrier_complete(bar, b.x, nloc, nx); b.st[0] = nloc; b.st[1] = nx; }
        const unsigned old = xb_add(&bar[XB_XSUB(b.x)], 1u);
        const unsigned gen = old / nloc;
        if (old + 1u == (gen + 1u) * nloc) {
            __builtin_amdgcn_fence(__ATOMIC_RELEASE, "agent");
            asm volatile("s_waitcnt vmcnt(0)" ::: "memory");
            const unsigned og = xb_add(&bar[XB_TOP], 1u);
            const unsigned tg = og / nx;
            if (og + 1u == (tg + 1u) * nx) xb_add(&bar[XB_TOPGEN], 1u);
            else XB_SPIN(xb_ld(&bar[XB_TOPGEN]) == tg, bar);
            __builtin_amdgcn_fence(__ATOMIC_ACQUIRE, "agent");
            xb_add(&bar[XB_XGEN(b.x)], 1u);
            asm volatile("s_waitcnt vmcnt(0)" ::: "memory");
        } else {
            XB_SPIN(xb_ld(&bar[XB_XGEN(b.x)]) == gen, bar);
            __builtin_amdgcn_fence(__ATOMIC_ACQUIRE, "agent");
            asm volatile("s_waitcnt vmcnt(0)" ::: "memory");
        }
    }
    __syncthreads();
}

struct Args { const float* in[34]; float* out; unsigned char* ws; int ph_lo, ph_hi; };
typedef __attribute__((address_space(4))) const Args CArgs;
enum { I_XP = 0, I_XS, I_CP, I_CS, I_SLH, I_SLC, I_SRE, I_SIM, I_WADA, I_BADA, I_WIN, I_BIN, I_WCONV, I_BCONV, I_WLG, I_BLG, I_LAM, I_WLO, I_ARE, I_AIM, I_LDT, I_BRE, I_BIM, I_CRE, I_CIM, I_SD, I_WGLU, I_WOUT, I_LN1G, I_LN1B, I_WUP, I_WDN, I_LN2G, I_LN2B };

__device__ __forceinline__ void transpose_item(const float* W, int K, int N, bf16* dst, int ldd, int mode, int halfc, bool dup, LAS float* scr, int item, int lane) {
    const int nblk = N / 32, kb = item / nblk, nb = item % nblk, k0 = 64 * kb, n0 = 32 * nb;
#pragma unroll 8
    for (int i = 0; i < 32; ++i) { const int kk = 2 * i + (lane >> 5); scr[kk * 33 + (lane & 31)] = W[(size_t)(k0 + kk) * N + n0 + (lane & 31)]; }
    LDS_WAIT(); asm volatile("" ::: "memory");
    int d0 = n0;
    if (mode == 1) { if (n0 < halfc) d0 = 256 * (n0 >> 7) + (n0 & 127); else { const int n1 = n0 - halfc; d0 = 256 * (n1 >> 7) + 128 + (n1 & 127); } }
    const int c = lane & 7;
#pragma unroll
    for (int j = 0; j < 4; ++j) { const int n = (lane >> 3) + 8 * j; const LAS float* s = scr + (8 * c) * 33 + n;
        u32x4 o; o.x = cvt_pk_bf16(s[0 * 33], s[1 * 33]); o.y = cvt_pk_bf16(s[2 * 33], s[3 * 33]); o.z = cvt_pk_bf16(s[4 * 33], s[5 * 33]); o.w = cvt_pk_bf16(s[6 * 33], s[7 * 33]);
        bf16* p = dst + (size_t)(d0 + n) * ldd + k0 + 8 * c;
        *(u32x4*)p = o; if (dup) *(u32x4*)(p + K) = o; }
    LDS_WAIT(); asm volatile("" ::: "memory");
}

__device__ __forceinline__ void convert_main(CArgs* a, int l, bool with_ada, LAS unsigned char* lds, int gw, int NGW, int wave, int lane) {
    LAS float* scr = (LAS float*)(lds + wave * 16384);
    unsigned char* ws = a->ws;
    constexpr int I0 = 16 * 160, I1 = 16 * 32, I2 = 16 * 64, I3 = 16 * 32, I4 = 16 * 192;
    const int total = I0 + I1 + I2 + I3 + (with_ada ? 2 * I4 : 0);
    for (int it = gw; it < total; it += NGW) {
        int r = it;
        if (r < I0) { transpose_item(a->in[I_WIN] + (size_t)l * D * NIN, D, NIN, (bf16*)(ws + WS_WIN), D, 0, 0, false, scr, r, lane); continue; } r -= I0;
        if (r < I1) { transpose_item(a->in[I_WLO] + (size_t)l * D * D, D, D, (bf16*)(ws + WS_W2), D, 0, 0, false, scr, r, lane); continue; } r -= I1;
        if (r < I2) { transpose_item(a->in[I_WGLU] + (size_t)l * D * 2048, D, 2048, (bf16*)(ws + WS_W2) + (size_t)1024 * D, D, 1, 1024, false, scr, r, lane); continue; } r -= I2;
        if (r < I3) { transpose_item(a->in[I_WOUT] + (size_t)l * D * D, D, D, (bf16*)(ws + WS_WOUT2), 2048, 0, 0, true, scr, r, lane); continue; } r -= I3;
        if (r < I4) { transpose_item(a->in[I_WADA], D, NADA, (bf16*)(ws + WS_WADA), D, 0, 0, false, scr, r, lane); continue; } r -= I4;
        transpose_item(a->in[I_WADA] + (size_t)D * NADA, D, NADA, (bf16*)(ws + WS_WADA) + (size_t)NADA * D, D, 0, 0, false, scr, r, lane);
    }
}
__device__ __forceinline__ void convert_ffn(CArgs* a, int l, LAS unsigned char* lds, int gw, int NGW, int wave, int lane) {
    LAS float* scr = (LAS float*)(lds + wave * 16384);
    unsigned char* ws = a->ws;
    constexpr int I0 = 16 * 176, I1 = 44 * 32;
    for (int it = gw; it < I0 + I1; it += NGW) {
        if (it < I0) transpose_item(a->in[I_WUP] + (size_t)l * D * 2 * DFF, D, 2 * DFF, (bf16*)(ws + WS_WUP), D, 1, DFF, false, scr, it, lane);
        else transpose_item(a->in[I_WDN] + (size_t)l * DFF * D, DFF, D, (bf16*)(ws + WS_WDN), DFF, 0, 0, false, scr, it - I0, lane);
    }
}

__device__ __forceinline__ void s5_tables(CArgs* a, int l, int g, LAS unsigned char* lds, int tid) {
    LAS float* Apr = (LAS float*)lds;
    LAS float* Api = Apr + 17 * 64;
    LAS float* Bbr = Api + 17 * 64;
    LAS float* Bbi = Bbr + 1024;
    LAS float* Cr = Bbi + 1024;
    LAS float* Ci = Cr + 1024;
    LAS float* Kl = Ci + 1024;
    unsigned char* ws = a->ws;
    float* aux = (float*)(ws + WS_S5AUX);
    const float* are = a->in[I_ARE] + (size_t)l * 4096 + g * 64; const float* aim = a->in[I_AIM] + (size_t)l * 4096 + g * 64;
    const double dt = exp((double)a->in[I_LDT][l * 64 + g]);
    for (int e = tid; e < 1024; e += 512) {
        const int p = e >> 4, q = e & 15;
        const double ar = are[p], ai = aim[p];
        const double mag = exp(ar * dt), th = ai * dt, abr = mag * cos(th), abi = mag * sin(th);
        const double nr = abr - 1.0, ni = abi, den = ar * ar + ai * ai;
        const double fr = (nr * ar + ni * ai) / den, fi = (ni * ar - nr * ai) / den;
        const double br = a->in[I_BRE][((size_t)l * 64 + g) * 1024 + e], bi = a->in[I_BIM][((size_t)l * 64 + g) * 1024 + e];
        const float bbr = (float)(fr * br - fi * bi), bbi = (float)(fr * bi + fi * br);
        Bbr[e] = bbr; Bbi[e] = bbi;
        aux[16384 + (size_t)g * 1024 + e] = bbr; aux[16384 + 65536 + (size_t)g * 1024 + e] = bbi;
        Cr[q * 64 + p] = a->in[I_CRE][((size_t)l * 64 + g) * 1024 + q * 64 + p]; Ci[q * 64 + p] = a->in[I_CIM][((size_t)l * 64 + g) * 1024 + q * 64 + p];
        if (q == 0) {
            double pr = 1.0, pi = 0.0;
            for (int k = 0; k <= 16; ++k) { Apr[k * 64 + p] = (float)pr; Api[k * 64 + p] = (float)pi; const double t = pr * abr - pi * abi; pi = pr * abi + pi * abr; pr = t; }
            aux[g * 64 + p] = (float)abr; aux[4096 + g * 64 + p] = (float)abi;
            aux[8192 + g * 64 + p] = Apr[16 * 64 + p]; aux[12288 + g * 64 + p] = Api[16 * 64 + p];
        }
    }
    __syncthreads();
    for (int e = tid; e < 4096; e += 512) {
        const int k = e >> 8, q = (e >> 4) & 15, qq = e & 15; float s = 0.f;
        for (int p = 0; p < 64; ++p) { const float abr_ = Apr[k * 64 + p] * Bbr[p * 16 + qq] - Api[k * 64 + p] * Bbi[p * 16 + qq], abi_ = Apr[k * 64 + p] * Bbi[p * 16 + qq] + Api[k * 64 + p] * Bbr[p * 16 + qq];
            s += Cr[q * 64 + p] * abr_ - Ci[q * 64 + p] * abi_; }
        Kl[e] = s;
    }
    __syncthreads();
    bf16* tw = (bf16*)(ws + WS_TW) + (size_t)g * 256 * 384;
    for (int ch = tid; ch < 256 * 48; ch += 512) {
        const int n = ch / 48, k0 = (ch % 48) * 8, t = n >> 4, q = n & 15; float v[8];
        if (k0 < 256) { const int s = k0 >> 4, qq0 = k0 & 15;
#pragma unroll
            for (int j = 0; j < 8; ++j) v[j] = (t >= s) ? Kl[((t - s) * 16 + q) * 16 + qq0 + j] : 0.f;
        } else { const int j0 = k0 - 256;
#pragma unroll
            for (int j = 0; j < 8; ++j) { const int jj = j0 + j, p = jj & 63; const float cr = Cr[q * 64 + p], ci = Ci[q * 64 + p], pr = Apr[(t + 1) * 64 + p], pi = Api[(t + 1) * 64 + p];
                v[j] = (jj < 64) ? (cr * pr - ci * pi) : -(cr * pi + ci * pr); } }
        u32x4 o; o.x = cvt_pk_bf16(v[0], v[1]); o.y = cvt_pk_bf16(v[2], v[3]); o.z = cvt_pk_bf16(v[4], v[5]); o.w = cvt_pk_bf16(v[6], v[7]);
        *(u32x4*)(tw + (size_t)n * 384 + k0) = o;
    }
    bf16* wst = (bf16*)(ws + WS_WST) + (size_t)g * 256 * 256;
    for (int ch = tid; ch < 256 * 32; ch += 512) {
        const int n = ch >> 5, k0 = (ch & 31) * 8, s = k0 >> 4, qq0 = k0 & 15, p = n & 63; float v[8];
#pragma unroll
        for (int j = 0; j < 8; ++j) { const float pr = Apr[(15 - s) * 64 + p], pi = Api[(15 - s) * 64 + p], br = Bbr[p * 16 + qq0 + j], bi = Bbi[p * 16 + qq0 + j];
            v[j] = (n < 64) ? (pr * br - pi * bi) : ((n < 128) ? (pr * bi + pi * br) : 0.f); }
        u32x4 o; o.x = cvt_pk_bf16(v[0], v[1]); o.y = cvt_pk_bf16(v[2], v[3]); o.z = cvt_pk_bf16(v[4], v[5]); o.w = cvt_pk_bf16(v[6], v[7]);
        *(u32x4*)(wst + (size_t)n * 256 + k0) = o;
    }
    __syncthreads();
}

__device__ __forceinline__ void row_phase(int mode, const float* src_p, const float* src_s, float* xout, bf16* uout, const float* gam, const float* bet,
                                          const float* ada_sh, const float* ada_sc, bool write_u, int gw, int NGW, int lane) {
    for (int row = gw; row < M; row += NGW) {
        const float* sr = (row < MP ? src_p + (size_t)row * D : src_s + (size_t)(row - MP) * D);
        f32x4 v[4];
#pragma unroll
        for (int j = 0; j < 4; ++j) v[j] = *(const f32x4*)(sr + 4 * lane + 256 * j);
        if (mode == 1) {
            float s = 0.f;
#pragma unroll
            for (int j = 0; j < 4; ++j) s += (v[j][0] + v[j][1]) + (v[j][2] + v[j][3]);
            const float mean = wave_sum(s, lane) * (1.f / D); float s2 = 0.f;
#pragma unroll
            for (int j = 0; j < 4; ++j) { v[j] = v[j] - mean; s2 += (v[j][0] * v[j][0] + v[j][1] * v[j][1]) + (v[j][2] * v[j][2] + v[j][3] * v[j][3]); }
            const float rstd = 1.f / sqrtf(wave_sum(s2, lane) * (1.f / D) + LN_EPS);
#pragma unroll
            for (int j = 0; j < 4; ++j) { const f32x4 gv = *(const f32x4*)(gam + 4 * lane + 256 * j), bv = *(const f32x4*)(bet + 4 * lane + 256 * j);
                v[j] = v[j] * rstd * gv + bv; *(f32x4*)(xout + (size_t)row * D + 4 * lane + 256 * j) = v[j]; }
        }
        if (write_u) {
            const int seq = seq_of_row(row);
#pragma unroll
            for (int j = 0; j < 4; ++j) { const f32x4 sc = *(const f32x4*)(ada_sc + (size_t)seq * 12288 + 4 * lane + 256 * j), sh = *(const f32x4*)(ada_sh + (size_t)seq * 12288 + 4 * lane + 256 * j);
                const f32x4 uu = v[j] * (sc + 1.f) + sh; u32x2 w; w.x = cvt_pk_bf16(uu[0], uu[1]); w.y = cvt_pk_bf16(uu[2], uu[3]);
                *(u32x2*)(uout + (size_t)row * D + 4 * lane + 256 * j) = w; }
        }
    }
}

constexpr int L_ZL = 0, L_VB = 16896, L_AA = 35328, L_BB = 70144, L_PS = 104960, L_BS = 107008, L_HC = 109056;
template <bool PROMPT>
__device__ __forceinline__ void lru_tile(CArgs* a, int l, int tb, int h, const bf16* zl, const bf16* zg, bf16* hg, LAS unsigned char* lds, int tid) {
    const int wave = tid >> 6, lane = tid & 63;
    LAS bf16* ZL = (LAS bf16*)(lds + L_ZL); LAS bf16* VB = (LAS bf16*)(lds + L_VB);
    LAS float* AA = (LAS float*)(lds + L_AA); LAS float* BB = (LAS float*)(lds + L_BB);
    LAS float* PS = (LAS float*)(lds + L_PS); LAS float* BS = (LAS float*)(lds + L_BS); LAS float* HC = (LAS float*)(lds + L_HC);
    const int ch0 = h * 64;
    bf16x8 Bw[8][2];
    {
        const float* wg = a->in[I_WLG] + (size_t)l * 2 * 16 * 4096;
#pragma unroll
        for (int nf = 0; nf < 8; ++nf)
#pragma unroll
            for (int ks = 0; ks < 2; ++ks) { const int n = 16 * nf + (lane & 15), gate = n >> 6, j = n & 63, k0 = 32 * ks + 8 * (lane >> 4);
                const float* p = wg + ((size_t)(gate * 16 + h) * 64 + k0) * 64 + j; u32x4 w;
                w.x = cvt_pk_bf16(p[0], p[64]); w.y = cvt_pk_bf16(p[128], p[192]); w.z = cvt_pk_bf16(p[256], p[320]); w.w = cvt_pk_bf16(p[384], p[448]);
                Bw[nf][ks] = __builtin_bit_cast(bf16x8, w); }
    }
    float bg0[4], bg1[4], nl8[4];
#pragma unroll
    for (int nf = 0; nf < 4; ++nf) { const int c = ch0 + 16 * nf + (lane & 15);
        bg0[nf] = a->in[I_BLG][(size_t)l * 2048 + c]; bg1[nf] = a->in[I_BLG][(size_t)l * 2048 + 1024 + c];
        const float lam = a->in[I_LAM][(size_t)l * 1024 + c]; const float x = -lam;
        const float sp = (x > 0.f ? x : 0.f) + log1pf(__expf(-fabsf(x)));
        nl8[nf] = -8.f * sp; }
    if (tid < 128) HC[tid] = 0.f;
    const int nchunk = PROMPT ? 16 : 1;
    const int rowbase0 = PROMPT ? tb * TSEQ : MP + tb * 128;
    const int sc = tid & 63, ss = tid >> 6;
    float hlast = 0.f;
    for (int ck = 0; ck < nchunk; ++ck) {
        const int rowbase = rowbase0 + ck * 128;
        __syncthreads();
        for (int pc = tid; pc < 131 * 8; pc += 512) { const int r = pc >> 3, c8 = pc & 7; const int row = rowbase - 3 + r;
            u32x4 w = (u32x4){0u, 0u, 0u, 0u};
            const bool ok = PROMPT ? (ck > 0 || r >= 3) : (r >= 3);
            if (ok) w = *(const u32x4*)(zl + (size_t)row * D + ch0 + c8 * 8);
            *(LAS u32x4*)(ZL + r * 64 + c8 * 8) = w; }
        __syncthreads();
        for (int it = tid; it < 1024; it += 512) { const int t = it >> 3, c8 = it & 7, cg = ch0 + c8 * 8;
            float v[8];
            { const f32x4 b0 = *(const f32x4*)(a->in[I_BCONV] + (size_t)l * 1024 + cg), b1 = *(const f32x4*)(a->in[I_BCONV] + (size_t)l * 1024 + cg + 4);
              v[0] = b0[0]; v[1] = b0[1]; v[2] = b0[2]; v[3] = b0[3]; v[4] = b1[0]; v[5] = b1[1]; v[6] = b1[2]; v[7] = b1[3]; }
#pragma unroll
            for (int k = 0; k < 4; ++k) {
                const f32x4 w0 = *(const f32x4*)(a->in[I_WCONV] + ((size_t)l * 4 + k) * 1024 + cg), w1 = *(const f32x4*)(a->in[I_WCONV] + ((size_t)l * 4 + k) * 1024 + cg + 4);
                float x[8];
                bool from_state = false; int idx = 0;
                if (!PROMPT) { idx = (t & 3) + k; from_state = idx < 3; }
                if (from_state) { const int seq = tb * 32 + (t >> 2); const float* sp = a->in[I_SLC] + (((size_t)l * 128 + seq) * 3 + idx) * 1024 + cg;
                    const f32x4 s0 = *(const f32x4*)sp, s1 = *(const f32x4*)(sp + 4); x[0] = s0[0]; x[1] = s0[1]; x[2] = s0[2]; x[3] = s0[3]; x[4] = s1[0]; x[5] = s1[1]; x[6] = s1[2]; x[7] = s1[3]; }
                else { const u32x4 w = *(const LAS u32x4*)(ZL + (t + k) * 64 + c8 * 8);
                    x[0] = bf_lo(w.x); x[1] = bf_hi(w.x); x[2] = bf_lo(w.y); x[3] = bf_hi(w.y); x[4] = bf_lo(w.z); x[5] = bf_hi(w.z); x[6] = bf_lo(w.w); x[7] = bf_hi(w.w); }
                v[0] += w0[0] * x[0]; v[1] += w0[1] * x[1]; v[2] += w0[2] * x[2]; v[3] += w0[3] * x[3]; v[4] += w1[0] * x[4]; v[5] += w1[1] * x[5]; v[6] += w1[2] * x[6]; v[7] += w1[3] * x[7];
            }
            *(LAS f32x4*)(BB + t * 68 + c8 * 8) = (f32x4){v[0], v[1], v[2], v[3]}; *(LAS f32x4*)(BB + t * 68 + c8 * 8 + 4) = (f32x4){v[4], v[5], v[6], v[7]};
            u32x4 o; o.x = cvt_pk_bf16(v[0], v[1]); o.y = cvt_pk_bf16(v[2], v[3]); o.z = cvt_pk_bf16(v[4], v[5]); o.w = cvt_pk_bf16(v[6], v[7]);
            *(LAS u32x4*)(VB + t * 72 + c8 * 8) = o; }
        __syncthreads();
        {
            f32x4 Dg[8];
#pragma unroll
            for (int nf = 0; nf < 8; ++nf) Dg[nf] = (f32x4){0.f, 0.f, 0.f, 0.f};
#pragma unroll
            for (int ks = 0; ks < 2; ++ks) { const bf16x8 af = *(const LAS bf16x8*)(VB + (16 * wave + (lane & 15)) * 72 + 32 * ks + 8 * (lane >> 4));
#pragma unroll
                for (int nf = 0; nf < 8; ++nf) Dg[nf] = __builtin_amdgcn_mfma_f32_16x16x32_bf16(af, Bw[nf][ks], Dg[nf], 0, 0, 0); }
#pragma unroll
            for (int nf = 0; nf < 4; ++nf)
#pragma unroll
                for (int rg = 0; rg < 4; ++rg) { const int t = 16 * wave + 4 * (lane >> 4) + rg, c = 16 * nf + (lane & 15);
                    const float r = sigm(Dg[nf][rg] + bg0[nf]), ig = sigm(Dg[nf + 4][rg] + bg1[nf]);
                    const float la = r * nl8[nf]; const float av = __expf(la); const float m = -expm1f(2.f * la);
                    const float v = BB[t * 68 + c];
                    AA[t * 68 + c] = av; BB[t * 68 + c] = sqrtf(m) * (ig * v); }
        }
        __syncthreads();
        if (PROMPT) {
            float P = 1.f, Bv = 0.f;
#pragma unroll 4
            for (int j = 0; j < 16; ++j) { const int t = 16 * ss + j; const float av = AA[t * 68 + sc], bv = BB[t * 68 + sc]; Bv = av * Bv + bv; P *= av; BB[t * 68 + sc] = Bv; AA[t * 68 + sc] = P; }
            PS[ss * 64 + sc] = P; BS[ss * 64 + sc] = Bv;
            __syncthreads();
            float carry = HC[(ck & 1) * 64 + sc];
            for (int s2 = 0; s2 < ss; ++s2) carry = PS[s2 * 64 + sc] * carry + BS[s2 * 64 + sc];
            if (ss == 7) { hlast = P * carry + Bv; HC[((ck + 1) & 1) * 64 + sc] = hlast; }
#pragma unroll 4
            for (int j = 0; j < 16; ++j) { const int t = 16 * ss + j; const float hv = BB[t * 68 + sc] + AA[t * 68 + sc] * carry;
                const size_t o = (size_t)(rowbase + t) * D + ch0 + sc; hg[o] = f2bf(hv * gelu_t(bf2f(zg[o]))); }
        } else {
            float hv = 0.f;
#pragma unroll 4
            for (int j = 0; j < 16; ++j) { const int t = 16 * ss + j; const int seq = tb * 32 + (t >> 2);
                if ((j & 3) == 0) hv = a->in[I_SLH][((size_t)l * 128 + seq) * 1024 + ch0 + sc];
                hv = AA[t * 68 + sc] * hv + BB[t * 68 + sc];
                const size_t o = (size_t)(rowbase + t) * D + ch0 + sc; hg[o] = f2bf(hv * gelu_t(bf2f(zg[o])));
                if ((j & 3) == 3) a->out[O_HS + ((size_t)l * 128 + seq) * 1024 + ch0 + sc] = hv; }
        }
    }
    if (PROMPT) {
        if (ss == 7) a->out[O_HP + ((size_t)l * 8 + tb) * 1024 + ch0 + sc] = hlast;
        if (tid < 192) { const int k = tid >> 6, c = tid & 63; a->out[O_CP + (((size_t)l * 8 + tb) * 3 + k) * 1024 + ch0 + c] = bf2f(zl[(size_t)(tb * TSEQ + TSEQ - 3 + k) * D + ch0 + c]); }
    } else {
        for (int e = tid; e < 32 * 3 * 64; e += 512) { const int c = e & 63, k = (e >> 6) % 3, sq = e / 192; const int seq = tb * 32 + sq;
            a->out[O_CS + (((size_t)l * 128 + seq) * 3 + k) * 1024 + ch0 + c] = bf2f(zl[(size_t)(MP + seq * 4 + 1 + k) * D + ch0 + c]); }
    }
    __syncthreads();
}

__device__ __forceinline__ void s5_sample_item(CArgs* a, int l, int seq, int g, const bf16* zs5s, bf16* gy, LAS float* xs  , int lane) {
    const float* aux = (const float*)(a->ws + WS_S5AUX);
    const int p = lane;
    const float ar = aux[g * 64 + p], ai = aux[4096 + g * 64 + p];
    float bbr[16], bbi[16];
#pragma unroll
    for (int q4 = 0; q4 < 4; ++q4) { const f32x4 r4 = *(const f32x4*)(aux + 16384 + (size_t)g * 1024 + p * 16 + q4 * 4), i4 = *(const f32x4*)(aux + 16384 + 65536 + (size_t)g * 1024 + p * 16 + q4 * 4);
#pragma unroll
        for (int j = 0; j < 4; ++j) { bbr[q4 * 4 + j] = r4[j]; bbi[q4 * 4 + j] = i4[j]; } }
    float xr = a->in[I_SRE][(((size_t)l * 128 + seq) * 64 + g) * 64 + p], xi = a->in[I_SIM][(((size_t)l * 128 + seq) * 64 + g) * 64 + p];
#pragma unroll
    for (int t = 0; t < 4; ++t) {
        const bf16* up = zs5s + (size_t)(seq * 4 + t) * D + g * 16;
        const u32x4 w0 = *(const u32x4*)up, w1 = *(const u32x4*)(up + 8);
        float uu[16] = {bf_lo(w0.x), bf_hi(w0.x), bf_lo(w0.y), bf_hi(w0.y), bf_lo(w0.z), bf_hi(w0.z), bf_lo(w0.w), bf_hi(w0.w), bf_lo(w1.x), bf_hi(w1.x), bf_lo(w1.y), bf_hi(w1.y), bf_lo(w1.z), bf_hi(w1.z), bf_lo(w1.w), bf_hi(w1.w)};
        float br = 0.f, bi = 0.f;
#pragma unroll
        for (int q = 0; q < 16; ++q) { br += bbr[q] * uu[q]; bi += bbi[q] * uu[q]; }
        const float nr = ar * xr - ai * xi + br, ni = ar * xi + ai * xr + bi; xr = nr; xi = ni;
        xs[(t * 2 + 0) * 64 + p] = xr; xs[(t * 2 + 1) * 64 + p] = xi;
    }
    a->out[O_RS + (((size_t)l * 128 + seq) * 64 + g) * 64 + p] = xr; a->out[O_IS + (((size_t)l * 128 + seq) * 64 + g) * 64 + p] = xi;
    LDS_WAIT(); asm volatile("" ::: "memory");
    const int t = lane >> 4, q = lane & 15;
    const float* cr = a->in[I_CRE] + (((size_t)l * 64 + g) * 16 + q) * 64; const float* ci = a->in[I_CIM] + (((size_t)l * 64 + g) * 16 + q) * 64;
    float y = 0.f;
#pragma unroll 4
    for (int p4 = 0; p4 < 16; ++p4) { const f32x4 c4 = *(const f32x4*)(cr + p4 * 4), d4 = *(const f32x4*)(ci + p4 * 4);
        const f32x4 r4 = *(const LAS f32x4*)(xs + (t * 2 + 0) * 64 + p4 * 4), i4 = *(const LAS f32x4*)(xs + (t * 2 + 1) * 64 + p4 * 4);
        y += (c4[0] * r4[0] + c4[1] * r4[1]) + (c4[2] * r4[2] + c4[3] * r4[3]) - ((d4[0] * i4[0] + d4[1] * i4[1]) + (d4[2] * i4[2] + d4[3] * i4[3])); }
    const float uq = bf2f(zs5s[(size_t)(seq * 4 + t) * D + g * 16 + q]);
    y += a->in[I_SD][(size_t)l * 1024 + g * 16 + q] * uq;
    gy[(size_t)(MP + seq * 4 + t) * D + g * 16 + q] = f2bf(gelu_t(y));
    LDS_WAIT(); asm volatile("" ::: "memory");
}

constexpr int N_PHASES = 3 + 9 * 2;
__device__ __forceinline__ void phase_body(const int ph, LAS unsigned char* lds, const int G, const int bx) {
        int tid = threadIdx.x; asm volatile("" : "+v"(tid));
        CArgs* ap = (CArgs*)__builtin_amdgcn_kernarg_segment_ptr(); asm volatile("" : "+s"(ap));
        unsigned char* ws = ap->ws;
        const int lane = tid & 63, wave = __builtin_amdgcn_readfirstlane(tid >> 6);
        const int gw = bx * NWAVES + wave, NGW = G * NWAVES;
        float* ada = (float*)(ws + WS_ADA);
        bf16* T1 = (bf16*)(ws + WS_T1); bf16* T2 = (bf16*)(ws + WS_T2); bf16* T3 = (bf16*)(ws + WS_T3);
        bf16* ZS = (bf16*)(ws + WS_T4); bf16* MAB = (bf16*)(ws + WS_T5); bf16* ZS5S = (bf16*)(ws + WS_ZS5S); bf16* HF = (bf16*)(ws + WS_HF);
        if (ph == 0) { if constexpr (PH_ON(0)) {
            convert_main(ap, 0, true, lds, gw, NGW, wave, lane);
            bf16* SC = (bf16*)(ws + WS_SC);
            for (int e = bx * 512 + tid; e < 256 * D / 4; e += G * 512) { const int row = e >> 8, c4 = (e & 255) * 4; u32x2 w = (u32x2){0u, 0u};
                if (row < NSEQ) { const f32x4 cv = *(const f32x4*)((row < 8 ? ap->in[I_CP] + (size_t)row * D : ap->in[I_CS] + (size_t)(row - 8) * D) + c4);
                    w.x = cvt_pk_bf16(silu_f(cv[0]), silu_f(cv[1])); w.y = cvt_pk_bf16(silu_f(cv[2]), silu_f(cv[3])); }
                *(u32x2*)(SC + (size_t)row * D + c4) = w; }
            __syncthreads();
            if (bx < 64) s5_tables(ap, 0, bx, lds, tid); }
        } else if (ph == 1) { if constexpr (PH_ON(1)) {
            pg8::Gemm g{D, D, D}; pg8::SchedStd S; S.o.init(1, 48, G, bx); S.A0 = S.A1 = (const char*)(ws + WS_SC); S.asplit = 1 << 30; S.at = 0; S.bt = (size_t)256 * D * 2; S.B0 = (const char*)(ws + WS_WADA);
            EpiAda E{ada, ap->in[I_BADA]};
            pg8::gemm_phase<EpiAda, pg8::SchedStd, false, true>(lds, g, S, E, tid); }
        } else if (ph == 2) { if constexpr (PH_ON(2)) {
            row_phase(0, ap->in[I_XP], ap->in[I_XS], nullptr, T1, nullptr, nullptr, ada + 0 * 1024, ada + 1 * 1024, true, gw, NGW, lane); }
        } else {
            const int l = (ph - 3) / 9, sp = (ph - 3) % 9;
            bf16* Ua = (l & 1) ? T3 : T1;
            bf16* Ub = (l & 1) ? T1 : T3;
            float* PRE = (float*)((l & 1) ? T2 : T1);
            float* adl = ada + (size_t)l * NADA;
            const float* xp = l == 0 ? ap->in[I_XP] : ap->out + O_Y; const float* xs = l == 0 ? ap->in[I_XS] : ap->out + O_Y + (size_t)MP * D;
            float* yo = ap->out + O_Y;
            if (sp == 0) { if constexpr (PH_ON(3)) {
                pg8::Gemm g{D, D, D}; pg8::SchedStd S; S.o.init(66, 20, G, bx); S.A0 = S.A1 = (const char*)Ua; S.asplit = 1 << 30; S.at = (size_t)256 * D * 2; S.bt = (size_t)256 * D * 2; S.B0 = (const char*)(ws + WS_WIN);
                EpiG1 E{T2, Ub, ZS, ZS5S, MAB, ap->in[I_BIN] + (size_t)l * NIN};
                pg8::gemm_phase<EpiG1, pg8::SchedStd, true, true>(lds, g, S, E, tid); }
            } else if (sp == 1) { if constexpr (PH_ON(4)) {
                if (bx < 128) { lru_tile<true>(ap, l, bx >> 4, bx & 15, T2, Ub, Ua, lds, tid); }
                else {
                    const int nb = G - 128, b2 = bx - 128;
                    for (int u0 = b2; u0 < 256; u0 += nb) {
                        pg8::Gemm g{384, 256, 256}; pg8::SchedS5 S{u0, 1, (const char*)ZS, (const char*)(ws + WS_WST), (size_t)256 * 384 * 2, (size_t)256 * 256 * 2};
                        const float* aux = (const float*)(ws + WS_S5AUX);
                        EpiS5A E{ZS, aux + 8192, aux + 12288, ap->out + O_RP + (size_t)l * 8 * 4096, ap->out + O_IP + (size_t)l * 8 * 4096};
                        pg8::gemm_phase<EpiS5A, pg8::SchedS5, false, true>(lds, g, S, E, tid);
                    }
                    asm volatile("" : "+v"(tid));
                    for (int tl = b2; tl < 64; tl += nb) lru_tile<false>(ap, l, tl >> 4, tl & 15, T2, Ub, Ua, lds, tid);
                } }
            } else if (sp == 2) { if constexpr (PH_ON(5)) {
                pg8::Gemm g{384, 384, 384};
                for (int u0 = bx; u0 < 256; u0 += G) {
                    pg8::SchedS5 S{u0, 1, (const char*)ZS, (const char*)(ws + WS_TW), (size_t)256 * 384 * 2, (size_t)256 * 384 * 2};
                    EpiS5B E{ZS, T2, ap->in[I_SD] + (size_t)l * 1024};
                    pg8::gemm_phase<EpiS5B, pg8::SchedS5, false, true>(lds, g, S, E, tid);
                }
                __syncthreads();
                asm volatile("" : "+v"(tid));
                const int lane2 = tid & 63, wave2 = __builtin_amdgcn_readfirstlane(tid >> 6);
                LAS float* xsw = (LAS float*)(lds + wave2 * 2048);
                for (int it = bx * NWAVES + wave2; it < 128 * 64; it += G * NWAVES) s5_sample_item(ap, l, it >> 6, it & 63, ZS5S, T2, xsw, lane2);
                }
            } else if (sp == 3) { if constexpr (PH_ON(6)) {
                pg8::Gemm g{D, D, D}; pg8::SchedStd S; S.o.init(66, 12, G, bx); S.A0 = (const char*)Ua; S.A1 = (const char*)T2; S.asplit = 4; S.at = (size_t)256 * D * 2; S.bt = (size_t)256 * D * 2; S.B0 = (const char*)(ws + WS_W2);
                EpiG2 E{MAB};
                pg8::gemm_phase<EpiG2, pg8::SchedStd, true, true>(lds, g, S, E, tid); }
            } else if (sp == 4) { if constexpr (PH_ON(7)) {
                pg8::Gemm g{2048, 2048, 2048}; pg8::SchedStd S; S.o.init(66, 4, G, bx); S.A0 = S.A1 = (const char*)MAB; S.asplit = 1 << 30; S.at = (size_t)256 * 2048 * 2; S.bt = (size_t)256 * 2048 * 2; S.B0 = (const char*)(ws + WS_WOUT2);
                EpiRes E{xp, xs, adl + 2 * 1024, PRE};
                pg8::gemm_phase<EpiRes, pg8::SchedStd, true, true>(lds, g, S, E, tid); }
            } else if (sp == 5) { if constexpr (PH_ON(8)) {
                row_phase(1, PRE, PRE + (size_t)MP * D, yo, Ub, ap->in[I_LN1G] + (size_t)l * D, ap->in[I_LN1B] + (size_t)l * D, adl + 3 * 1024, adl + 4 * 1024, true, gw, NGW, lane);
                convert_ffn(ap, l, lds, gw, NGW, wave, lane); }
            } else if (sp == 6) { if constexpr (PH_ON(9)) {
                pg8::Gemm g{D, D, D}; pg8::SchedStd S; S.o.init(66, 22, G, bx); S.A0 = S.A1 = (const char*)Ub; S.asplit = 1 << 30; S.at = (size_t)256 * D * 2; S.bt = (size_t)256 * D * 2; S.B0 = (const char*)(ws + WS_WUP);
                EpiG4 E{HF};
                pg8::gemm_phase<EpiG4, pg8::SchedStd, true, true>(lds, g, S, E, tid); }
            } else if (sp == 7) { if constexpr (PH_ON(10)) {
                pg8::Gemm g{DFF, DFF, DFF}; pg8::SchedStd S; S.o.init(66, 4, G, bx); S.A0 = S.A1 = (const char*)HF; S.asplit = 1 << 30; S.at = (size_t)256 * DFF * 2; S.bt = (size_t)256 * DFF * 2; S.B0 = (const char*)(ws + WS_WDN);
                EpiRes E{yo, yo + (size_t)MP * D, adl + 5 * 1024, PRE};
                pg8::gemm_phase<EpiRes, pg8::SchedStd, true, true>(lds, g, S, E, tid); }
            } else { if constexpr (PH_ON(11)) {
                const bool more = (l + 1 < 2);
                row_phase(1, PRE, PRE + (size_t)MP * D, yo, Ub, ap->in[I_LN2G] + (size_t)l * D, ap->in[I_LN2B] + (size_t)l * D, adl + NADA + 0 * 1024, adl + NADA + 1 * 1024, more, gw, NGW, lane);
                if (more) { convert_main(ap, l + 1, false, lds, gw, NGW, wave, lane); __syncthreads(); if (bx < 64) s5_tables(ap, l + 1, bx, lds, tid); } }
            }
        }
}

__global__ void __launch_bounds__(NWAVES * 64, 2) hawk_fwd(Args args) {
    extern __shared__ __attribute__((aligned(16))) unsigned char lds_raw[];
    LAS unsigned char* lds = (LAS unsigned char*)lds_raw;
    volatile LAS unsigned* MISC = (volatile LAS unsigned*)(lds + MISC_OFF);
    const int G = gridDim.x, bx = blockIdx.x;
    for (int u = threadIdx.x; u < (LDS_BYTES - RING_BYTES) / 4; u += NWAVES * 64) ((LAS unsigned*)(lds + RING_BYTES))[u] = 0u;
    __syncthreads();
#if MK_ONE_LAUNCH
    XcdBarrier bar = xcd_barrier_post((unsigned*)(args.ws + WS_CTL) + 1024, MISC + 8);
#define SEAM(k) if ((k) + 1 < hi) xcd_barrier(bar);
#else
    (void)MISC;
#define SEAM(k)
#endif
    const int lo = args.ph_lo, hi = args.ph_hi;
#define RUN(k) if (lo <= (k) && (k) < hi) { phase_body((k), lds, G, bx); SEAM(k) }
    RUN(0) RUN(1) RUN(2)
    RUN(3) RUN(4) RUN(5) RUN(6) RUN(7) RUN(8) RUN(9) RUN(10) RUN(11)
    RUN(12) RUN(13) RUN(14) RUN(15) RUN(16) RUN(17) RUN(18) RUN(19) RUN(20)
#undef RUN
#undef SEAM
}

extern "C" void kernel_launch(void* const* d_in, const int* in_sizes, int n_in, void* d_out, int out_size, void* d_ws, size_t ws_size, hipStream_t stream) {
    static int grid = 0;
    if (grid == 0) {
        if (n_in != 34 || ws_size < WS_END) { fprintf(stderr, "kernel_launch: unexpected n_in %d / ws_size %zu (need %zu)\n", n_in, ws_size, (size_t)WS_END); grid = -1; return; }
        int dev = 0, cus = 0, per_cu = 0;
        (void)hipGetDevice(&dev); (void)hipDeviceGetAttribute(&cus, hipDeviceAttributeMultiprocessorCount, dev);
        if (hipFuncSetAttribute((const void*)hawk_fwd, hipFuncAttributeMaxDynamicSharedMemorySize, LDS_BYTES) != hipSuccess) { fprintf(stderr, "kernel_launch: hipFuncSetAttribute failed\n"); grid = -1; return; }
        if (hipOccupancyMaxActiveBlocksPerMultiprocessor(&per_cu, (const void*)hawk_fwd, NWAVES * 64, LDS_BYTES) != hipSuccess || per_cu < 1) { fprintf(stderr, "kernel_launch: occupancy query says %d\n", per_cu); per_cu = 1; }
        (void)hipGetLastError();
        grid = cus > 0 ? cus : 256;
    }
    if (grid < 0) return;
    (void)hipMemsetAsync((char*)d_ws + WS_CTL, 0, CTL_ZERO_BYTES, stream);
    Args a{};
    for (int i = 0; i < 34; ++i) a.in[i] = (const float*)d_in[i];
    a.out = (float*)d_out; a.ws = (unsigned char*)d_ws;
#if MK_ONE_LAUNCH
    a.ph_lo = 0; a.ph_hi = N_PHASES;
    void* kargs[] = {&a};
    hipError_t e = hipLaunchCooperativeKernel((const void*)hawk_fwd, dim3(grid), dim3(NWAVES * 64), kargs, LDS_BYTES, stream);
    if (e != hipSuccess) fprintf(stderr, "kernel_launch: cooperative launch failed: %s\n", hipGetErrorString(e));
#else
    for (int ph = 0; ph < N_PHASES; ++ph) { a.ph_lo = ph; a.ph_hi = ph + 1; hipLaunchKernelGGL(hawk_fwd, dim3(grid), dim3(NWAVES * 64), LDS_BYTES, stream, a); }
#endif
}
```

```cpp
#include <hip/hip_runtime.h>
#include <cstdio>
#include <cstdint>

#define LAS __attribute__((address_space(3)))
#define GAS __attribute__((address_space(1)))
typedef unsigned short bf16;
typedef short bf16x8 __attribute__((ext_vector_type(8)));
typedef float f32x4 __attribute__((ext_vector_type(4)));
typedef float f32x2 __attribute__((ext_vector_type(2)));
typedef unsigned u32x4 __attribute__((ext_vector_type(4)));
typedef unsigned u32x2 __attribute__((ext_vector_type(2)));

#ifndef MK_ONE_LAUNCH
#define MK_ONE_LAUNCH 1
#endif
#ifndef PH_MASK
#define PH_MASK 0xFFF
#endif
#define PH_ON(k) (((PH_MASK) >> (k)) & 1)

constexpr int D = 1024, MP = 16384, MS = 512, M = MP + MS, TSEQ = 2048, NSEQ = 136;
constexpr int NIN = 5120, DFF = 2816, NADA = 6144;
constexpr float DN_ALPHA = 1.4142135623730951f, LN_EPS = 1e-5f;
constexpr int NWAVES = 8;

constexpr size_t MiB = 1u << 20;
constexpr size_t WS_CTL = 0, CTL_ZERO_BYTES = 64 * 1024;
constexpr size_t WS_ADA = 1 * MiB;
constexpr size_t WS_WIN = 8 * MiB;
constexpr size_t WS_W2 = 18 * MiB;
constexpr size_t WS_WOUT2 = 24 * MiB;
constexpr size_t WS_TW = 28 * MiB;
constexpr size_t WS_WST = 40 * MiB;
constexpr size_t WS_S5AUX = 48 * MiB;
constexpr size_t WS_SC = 49 * MiB;
constexpr size_t WS_ZS5S = 50 * MiB;
constexpr size_t U1 = (size_t)M * D * 2;
constexpr size_t WS_T1 = 52 * MiB, WS_T2 = WS_T1 + U1, WS_T3 = WS_T2 + U1, WS_T4 = WS_T3 + U1;
constexpr size_t WS_T5 = WS_T4 + 48 * MiB;
constexpr size_t WS_END = WS_T5 + 2 * U1;
constexpr size_t WS_HF = WS_T4;
constexpr size_t WS_WUP = 242 * MiB;
constexpr size_t WS_WDN = 253 * MiB;
constexpr size_t WS_WADA = WS_T5;
static_assert(WS_HF + (size_t)M * DFF * 2 <= WS_WUP && WS_WDN + (size_t)D * DFF * 2 <= WS_END, "ws map");
static_assert(WS_END <= 280789504ull, "ws map exceeds the guaranteed workspace");
constexpr size_t O_Y = 0, O_HP = 17301504, O_HS = 17317888, O_CP = 17580032, O_CS = 17629184, O_RP = 18415616, O_RS = 18481152, O_IP = 19529728, O_IS = 19595264;

constexpr int RING_BYTES = 131072, MISC_OFF = RING_BYTES + 320, LDS_BYTES = 147456;

__device__ __forceinline__ unsigned cvt_pk_bf16(float lo, float hi) { unsigned r; asm volatile("v_cvt_pk_bf16_f32 %0, %1, %2" : "=v"(r) : "v"(lo), "v"(hi)); return r; }
__device__ __forceinline__ float bf_lo(unsigned w) { return __uint_as_float(w << 16); }
__device__ __forceinline__ float bf_hi(unsigned w) { return __uint_as_float(w & 0xffff0000u); }
__device__ __forceinline__ float bf2f(bf16 b) { return __uint_as_float(((unsigned)b) << 16); }
__device__ __forceinline__ bf16 f2bf(float f) { return (bf16)(cvt_pk_bf16(f, 0.f) & 0xffffu); }
__device__ __forceinline__ float sigm(float x) { return __builtin_amdgcn_rcpf(1.f + __expf(-x)); }
__device__ __forceinline__ float gelu_t(float x) { return x * sigm(x * (1.5957691216f + 0.0713548163f * x * x)); }
__device__ __forceinline__ float silu_f(float x) { return x * sigm(x); }
__device__ __forceinline__ int seq_of_row(int row) { return row < MP ? (row >> 11) : 8 + ((row - MP) >> 2); }
__device__ __forceinline__ float wave_sum(float v, int lane) {
#pragma unroll
    for (int o = 1; o < 64; o <<= 1) v += __int_as_float(__builtin_amdgcn_ds_bpermute((lane ^ o) << 2, __float_as_int(v)));
    return v;
}
#define LDS_WAIT() asm volatile("s_waitcnt lgkmcnt(0)" ::: "memory")
#define VM_WAIT() asm volatile("s_waitcnt vmcnt(0)" ::: "memory")

namespace pg8 {
constexpr int BM = 256, BK = 64, HALF = 128, HTB = HALF * BK * 2, STAGE_BYTES = 8 * HTB, NXCD = 8, WGM = 8;
__host__ __device__ __forceinline__ int lds_byte(int r, int c) { const int st = (r >> 4) * 2 + (c >> 5), rr = r & 15, cc = c & 31, ob = rr * 64 + cc * 2; return st * 1024 + (ob ^ (((ob >> 9) & 1) << 5)); }
__host__ __device__ __forceinline__ void stage_rc(int b, int& R, int& C) { const int st = b / 1024, sb = b % 1024, swz = sb ^ (((sb >> 9) & 1) << 5); R = (st >> 1) * 16 + swz / 64; C = (st & 1) * 32 + (swz % 64) / 2; }
__host__ __device__ __forceinline__ int perm32(int rho) { const int n = rho >> 4, i = rho & 15; return 8 * (i >> 2) + 4 * n + (i & 3); }

struct Unit { int pm, pn; };
struct Gemm { int lda, ldb, K; };

struct StaticOrder {
    int nM, nN, nwg, G, c;
    __device__ void init(int nM_, int nN_, int G_, int c_) { nM = nM_; nN = nN_; nwg = nM * nN; G = G_; c = c_; }
    __device__ bool next(int i, Unit& u) const {
        const long L = (long)i * G + c; if (L >= nwg) return false;
        int wgid = (int)L; { const int q = nwg / NXCD, r = nwg % NXCD, xcd = wgid % NXCD, off = wgid / NXCD; wgid = (xcd < r ? xcd * (q + 1) : r * (q + 1) + (xcd - r) * q) + off; }
        const int nig = WGM * nN, gid = wgid / nig, fm = gid * WGM, gsz = (nM - fm) < WGM ? (nM - fm) : WGM;
        u.pm = fm + ((wgid % nig) % gsz); u.pn = (wgid % nig) / gsz; return true;
    }
};
struct SchedStd {
    StaticOrder o; const char* A0; const char* A1; int asplit; size_t at, bt; const char* B0;
    __device__ __forceinline__ bool next(int i, Unit& u) const { return o.next(i, u); }
    __device__ __forceinline__ const char* A(const Unit& u) const { return (u.pn < asplit ? A0 : A1) + (size_t)u.pm * at; }
    __device__ __forceinline__ const char* B(const Unit& u) const { return B0 + (size_t)u.pn * bt; }
};
struct SchedS5 {
    int u0, n; const char* A0; const char* B0; size_t at, bt;
    __device__ __forceinline__ bool next(int i, Unit& u) const { if (i >= n) return false; u.pm = u0 + i; u.pn = (u0 + i) >> 2; return true; }
    __device__ __forceinline__ const char* A(const Unit& u) const { return A0 + (size_t)u.pm * at; }
    __device__ __forceinline__ const char* B(const Unit& u) const { return B0 + (size_t)u.pn * bt; }
};

template <class Epi, class Sched, bool ALIGN_EPI, bool SP2>
__device__ __forceinline__ void gemm_phase(LAS unsigned char* lds, const Gemm g, const Sched& S, const Epi& E, const int tid_in) {
    int tid = tid_in; asm volatile("" : "+v"(tid));
    const int wid = __builtin_amdgcn_readfirstlane(tid >> 6), lane = tid & 63, wr = wid >> 2, wc = wid & 3, fr = lane & 15, fq = lane >> 4;
    const int nt = g.K / BK;
    unsigned voffA[2], voffB[2];
#pragma unroll
    for (int i = 0; i < 2; ++i) { int R, C; stage_rc(tid * 16 + i * 8192, R, C); const int Rb = Epi::PERM ? ((R & ~31) + perm32(R & 31)) : R;
        voffA[i] = (unsigned)(R * g.lda + C) * 2u; voffB[i] = (unsigned)(Rb * g.ldb + C) * 2u; }
    const size_t kstep = (size_t)(BK * 2);
    const size_t hA = (size_t)HALF * g.lda * 2, hB = (size_t)HALF * g.ldb * 2;
    const unsigned ldsw = (unsigned)wid * 1024u;
    const int aoff = lds_byte(wr * 64 + fr, fq * 8), boff = lds_byte(wc * 32 + fr, fq * 8);
#define PG8_SA(b, h) (((b) * 2 + (h)) * HTB)
#define PG8_SB(b, h) ((4 + (b) * 2 + (h)) * HTB)
#define PG8_STAGE(bufoff, gbase, voff) do { _Pragma("unroll") for (int _i = 0; _i < 2; ++_i) \
        __builtin_amdgcn_global_load_lds((const unsigned*)((const char*)(gbase) + (voff)[_i]), (LAS unsigned*)(lds + (bufoff) + ldsw + _i * 8192), 16, 0, 0); } while (0)
#define PG8_LDA(dst, b, h) do { _Pragma("unroll") for (int m = 0; m < 4; ++m) _Pragma("unroll") for (int k = 0; k < 2; ++k) dst[m][k] = *(const LAS bf16x8*)(lds + PG8_SA(b, h) + aoff + m * 2048 + k * 1024); } while (0)
#define PG8_LDB(dst, b, h) do { _Pragma("unroll") for (int n = 0; n < 2; ++n) _Pragma("unroll") for (int k = 0; k < 2; ++k) dst[n][k] = *(const LAS bf16x8*)(lds + PG8_SB(b, h) + boff + n * 2048 + k * 1024); } while (0)
#define PG8_MMA(ai, bj, At, Bt) do { __builtin_amdgcn_s_setprio(1); _Pragma("unroll") for (int m = 0; m < 4; ++m) _Pragma("unroll") for (int n = 0; n < 2; ++n) _Pragma("unroll") for (int k = 0; k < 2; ++k) \
        acc[ai][bj][m][n] = __builtin_amdgcn_mfma_f32_16x16x32_bf16(Bt[n][k], At[m][k], acc[ai][bj][m][n], 0, 0, 0); __builtin_amdgcn_s_setprio(0); } while (0)
#define PG8_WAIT_V(n) asm volatile("s_waitcnt vmcnt(" #n ")" ::: "memory")
#define PG8_WAIT_L(n) asm volatile("s_waitcnt lgkmcnt(" #n ")" ::: "memory")
#define PG8_BAR __builtin_amdgcn_s_barrier()
#define PG8_SCHED __builtin_amdgcn_sched_barrier(0)
    Unit cur, nxt; int ui = 0;
    if (!S.next(0, cur)) return;
    f32x4 acc[2][2][4][2];
#pragma unroll
    for (int a = 0; a < 2; ++a)
#pragma unroll
        for (int b = 0; b < 2; ++b)
#pragma unroll
            for (int m = 0; m < 4; ++m)
#pragma unroll
                for (int n = 0; n < 2; ++n) acc[a][b][m][n] = (f32x4){0.f, 0.f, 0.f, 0.f};
    bf16x8 At[4][2], B0[2][2], B1[2][2];
    const char* cA = S.A(cur); const char* cB = S.B(cur);
    if constexpr (SP2) {
        PG8_STAGE(PG8_SB(0, 0), cB, voffB); PG8_STAGE(PG8_SB(0, 1), cB + hB, voffB); PG8_STAGE(PG8_SA(0, 0), cA, voffA); PG8_STAGE(PG8_SA(0, 1), cA + hA, voffA);
        if (wr == 1) PG8_BAR;
        PG8_WAIT_V(2); PG8_BAR;
        PG8_STAGE(PG8_SB(1, 0), cB + kstep, voffB); PG8_STAGE(PG8_SA(1, 0), cA + kstep, voffA); PG8_STAGE(PG8_SB(1, 1), cB + hB + kstep, voffB);
        PG8_WAIT_V(6); PG8_BAR;
    } else {
        PG8_STAGE(PG8_SB(0, 0), cB, voffB); PG8_STAGE(PG8_SA(0, 0), cA, voffA); PG8_STAGE(PG8_SB(0, 1), cB + hB, voffB); PG8_STAGE(PG8_SA(0, 1), cA + hA, voffA);
        if (wr == 1) PG8_BAR;
        PG8_WAIT_V(4); PG8_BAR;
        PG8_STAGE(PG8_SB(1, 0), cB + kstep, voffB); PG8_STAGE(PG8_SA(1, 0), cA + kstep, voffA); PG8_STAGE(PG8_SB(1, 1), cB + hB + kstep, voffB);
        PG8_WAIT_V(6); PG8_BAR;
    }
    for (;;) {
        const bool has_next = S.next(ui + 1, nxt);
        const char* nA = has_next ? S.A(nxt) : cA; const char* nB = has_next ? S.B(nxt) : cB;
#pragma unroll 1
        for (int t = 0; t < nt; t += 2) {
            const bool last = (t == nt - 2);
            const char* a1 = cA + (size_t)(t + 1) * kstep;
            const char* a2 = last ? nA : cA + (size_t)(t + 2) * kstep; const char* b2 = last ? nB : cB + (size_t)(t + 2) * kstep;
            const char* a3 = a2 + kstep; const char* b3 = b2 + kstep;
            if constexpr (SP2) {
            PG8_LDB(B0, 0, 0); PG8_LDB(B1, 0, 1); PG8_SCHED; PG8_LDA(At, 0, 0); PG8_STAGE(PG8_SA(1, 1), a1 + hA, voffA);
            PG8_WAIT_V(8); PG8_WAIT_L(0); PG8_BAR; PG8_MMA(0, 0, At, B0); PG8_MMA(0, 1, At, B1); PG8_BAR; PG8_SCHED;
            PG8_LDA(At, 0, 1); PG8_STAGE(PG8_SB(0, 0), b2, voffB); PG8_STAGE(PG8_SB(0, 1), b2 + hB, voffB); PG8_STAGE(PG8_SA(0, 0), a2, voffA);
            PG8_WAIT_V(8); PG8_WAIT_L(0); PG8_BAR; PG8_MMA(1, 0, At, B0); PG8_MMA(1, 1, At, B1); PG8_BAR; PG8_SCHED;
            PG8_LDB(B0, 1, 0); PG8_LDB(B1, 1, 1); PG8_SCHED; PG8_LDA(At, 1, 0); PG8_STAGE(PG8_SA(0, 1), a2 + hA, voffA);
            PG8_WAIT_V(8); PG8_WAIT_L(0); PG8_BAR; PG8_MMA(0, 0, At, B0); PG8_MMA(0, 1, At, B1); PG8_BAR; PG8_SCHED;
            PG8_LDA(At, 1, 1); PG8_STAGE(PG8_SB(1, 0), b3, voffB); PG8_STAGE(PG8_SB(1, 1), b3 + hB, voffB); PG8_STAGE(PG8_SA(1, 0), a3, voffA);
            PG8_WAIT_V(8); PG8_WAIT_L(0); PG8_BAR; PG8_MMA(1, 0, At, B0); PG8_MMA(1, 1, At, B1); PG8_BAR; PG8_SCHED;
            } else {
            PG8_LDB(B0, 0, 0); PG8_SCHED; PG8_LDA(At, 0, 0); PG8_STAGE(PG8_SA(1, 1), a1 + hA, voffA);
            PG8_WAIT_L(8); PG8_BAR; PG8_WAIT_L(0); PG8_MMA(0, 0, At, B0); PG8_BAR; PG8_SCHED;
            PG8_LDB(B1, 0, 1); PG8_STAGE(PG8_SB(0, 0), b2, voffB);
            PG8_BAR; PG8_WAIT_L(0); PG8_MMA(0, 1, At, B1); PG8_BAR;
            PG8_LDA(At, 0, 1); PG8_STAGE(PG8_SA(0, 0), a2, voffA);
            PG8_BAR; PG8_WAIT_L(0); PG8_MMA(1, 0, At, B0); PG8_BAR; PG8_SCHED;
            PG8_STAGE(PG8_SB(0, 1), b2 + hB, voffB);
            PG8_WAIT_V(6); PG8_BAR; PG8_MMA(1, 1, At, B1); PG8_BAR;
            PG8_LDB(B0, 1, 0); PG8_SCHED; PG8_LDA(At, 1, 0); PG8_STAGE(PG8_SA(0, 1), a2 + hA, voffA);
            PG8_WAIT_L(8); PG8_BAR; PG8_WAIT_L(0); PG8_MMA(0, 0, At, B0); PG8_BAR; PG8_SCHED;
            PG8_LDB(B1, 1, 1); PG8_STAGE(PG8_SB(1, 0), b3, voffB);
            PG8_BAR; PG8_WAIT_L(0); PG8_MMA(0, 1, At, B1); PG8_BAR;
            PG8_LDA(At, 1, 1); PG8_STAGE(PG8_SA(1, 0), a3, voffA);
            PG8_BAR; PG8_WAIT_L(0); PG8_MMA(1, 0, At, B0); PG8_BAR; PG8_SCHED;
            PG8_STAGE(PG8_SB(1, 1), b3 + hB, voffB);
            PG8_WAIT_V(6); PG8_BAR; PG8_MMA(1, 1, At, B1); PG8_BAR;
            }
        }
        if constexpr (ALIGN_EPI) { if (wr == 0) PG8_BAR; }
        if constexpr (!Epi::AFTER_DRAIN) { E(acc, cur, wr, wc, fr, fq); }
        if (!has_next) break;
#pragma unroll
        for (int a = 0; a < 2; ++a)
#pragma unroll
            for (int b = 0; b < 2; ++b)
#pragma unroll
                for (int m = 0; m < 4; ++m)
#pragma unroll
                    for (int n = 0; n < 2; ++n) acc[a][b][m][n] = (f32x4){0.f, 0.f, 0.f, 0.f};
        cur = nxt; cA = nA; cB = nB; ++ui;
        if constexpr (ALIGN_EPI) { if (wr == 1) PG8_BAR; }
    }
    PG8_WAIT_V(0);
    if constexpr (!ALIGN_EPI) { if (wr == 0) PG8_BAR; }
    PG8_BAR;
    if constexpr (Epi::AFTER_DRAIN) { E.fused(acc, cur, wr, wc, fr, fq, lds, wid, lane); }
#undef PG8_SA
#undef PG8_SB
#undef PG8_STAGE
#undef PG8_LDA
#undef PG8_LDB
#undef PG8_MMA
#undef PG8_WAIT_V
#undef PG8_WAIT_L
#undef PG8_BAR
#undef PG8_SCHED
}
}
typedef const f32x4 (&AccRef)[2][2][4][2];

__device__ __forceinline__ u32x4 pack8(f32x4 v0, f32x4 v1) { u32x4 w; w.x = cvt_pk_bf16(v0[0], v0[1]); w.y = cvt_pk_bf16(v0[2], v0[3]); w.z = cvt_pk_bf16(v1[0], v1[1]); w.w = cvt_pk_bf16(v1[2], v1[3]); return w; }

struct EpiAda {
    static constexpr bool PERM = false, AFTER_DRAIN = false;
    float* ada; const float* bias;
    __device__ __forceinline__ void operator()(AccRef acc, const pg8::Unit& u, int wr, int wc, int fr, int fq) const {
        const int col0 = u.pn * 256 + wc * 32 + 4 * fq;
#pragma unroll
        for (int ai = 0; ai < 2; ++ai)
#pragma unroll
            for (int m = 0; m < 4; ++m) { const int row = ai * 128 + wr * 64 + m * 16 + fr;
                if (row < NSEQ) {
#pragma unroll
                    for (int bj = 0; bj < 2; ++bj)
#pragma unroll
                        for (int n = 0; n < 2; ++n) { const int c = col0 + bj * 128 + n * 16; *(f32x4*)(ada + (size_t)row * 12288 + c) = acc[ai][bj][m][n] + *(const f32x4*)(bias + c); } } }
    }
};
struct EpiG1 {
    static constexpr bool PERM = true, AFTER_DRAIN = false;
    bf16 *zl, *zg, *zs, *zs5s, *mab; const float* bias;
    __device__ __forceinline__ void operator()(AccRef acc, const pg8::Unit& u, int wr, int wc, int fr, int fq) const {
        const int pn = u.pn, cb = wc * 32 + 8 * fq;
        f32x4 bv[2][2];
#pragma unroll
        for (int bj = 0; bj < 2; ++bj)
#pragma unroll
            for (int n = 0; n < 2; ++n) bv[bj][n] = *(const f32x4*)(bias + pn * 256 + bj * 128 + cb + 4 * n);
#pragma unroll
        for (int ai = 0; ai < 2; ++ai)
#pragma unroll
            for (int m = 0; m < 4; ++m) { const int row = u.pm * 256 + ai * 128 + wr * 64 + m * 16 + fr;
#pragma unroll
                for (int bj = 0; bj < 2; ++bj) {
                    const u32x4 w = pack8(acc[ai][bj][m][0] + bv[bj][0], acc[ai][bj][m][1] + bv[bj][1]);
                    const int col = pn * 256 + bj * 128 + cb;
                    bf16* dst;
                    if (pn < 4) dst = zl + (size_t)row * D + col;
                    else if (pn < 8) dst = zg + (size_t)row * D + (col - 1024);
                    else if (pn < 12) { const int j = col - 2048;
                        if (row < MP) dst = zs + ((size_t)(j >> 4) * 1024 + (row >> 4)) * 384 + (row & 15) * 16 + (j & 15);
                        else dst = zs5s + (size_t)(row - MP) * D + j; }
                    else dst = mab + (size_t)row * 2048 + (col - 3072);
                    *(u32x4*)dst = w; }
                asm volatile("" ::: "memory"); }
    }
};
struct EpiS5A {
    static constexpr bool PERM = false, AFTER_DRAIN = true;
    bf16* zs; const float* a16re; const float* a16im; float* ore; float* oim;
    __device__ __forceinline__ void fused(AccRef acc, const pg8::Unit& u, int wr, int wc, int fr, int fq, LAS unsigned char* lds, int wid, int lane) const {
        LAS f32x4* S4 = (LAS f32x4*)lds;
#pragma unroll
        for (int ai = 0; ai < 2; ++ai)
#pragma unroll
            for (int m = 0; m < 4; ++m) { const int row = ai * 128 + wr * 64 + m * 16 + fr;
#pragma unroll
                for (int n = 0; n < 2; ++n) { const int c4 = wc * 8 + n * 4 + fq; S4[row * 32 + (c4 ^ (row & 31))] = acc[ai][0][m][n]; } }
        LDS_WAIT(); __syncthreads();
        const int g = u.pm >> 2, mt = u.pm & 3, tid = wid * 64 + lane;
        if (tid < 128) {
            const int sg = tid >> 6, p = tid & 63;
            const float ar = a16re[g * 64 + p], ai_ = a16im[g * 64 + p];
            float hr = 0.f, hi = 0.f;
            const LAS float* Sf = (const LAS float*)lds;
            bf16* hrow = zs + ((size_t)g * 1024 + mt * 256 + sg * 128) * 384 + 256;
            for (int c = 0; c < 128; ++c) {
                const int row = sg * 128 + c;
                hrow[(size_t)c * 384 + p] = f2bf(hr); hrow[(size_t)c * 384 + 64 + p] = f2bf(hi);
                const float sr = Sf[(row * 32 + ((p >> 2) ^ (row & 31))) * 4 + (p & 3)];
                const float si = Sf[(row * 32 + (((64 + p) >> 2) ^ (row & 31))) * 4 + (p & 3)];
                const float nr = ar * hr - ai_ * hi + sr, ni = ar * hi + ai_ * hr + si;
                hr = nr; hi = ni;
            }
            const int b = mt * 2 + sg;
            ore[(b * 64 + g) * 64 + p] = hr; oim[(b * 64 + g) * 64 + p] = hi;
        }
        __syncthreads();
    }
};
struct EpiS5B {
    static constexpr bool PERM = true, AFTER_DRAIN = false;
    const bf16* zs; bf16* gy; const float* dvec;
    __device__ __forceinline__ void operator()(AccRef acc, const pg8::Unit& u, int wr, int wc, int fr, int fq) const {
        const int g = u.pm >> 2, mt = u.pm & 3, q0 = 8 * (fq & 1), t0 = 2 * wc + (fq >> 1);
        const f32x4 d0 = *(const f32x4*)(dvec + g * 16 + q0), d1 = *(const f32x4*)(dvec + g * 16 + q0 + 4);
        const int cc0 = mt * 256 + wr * 64 + fr;
        const bf16* zb = zs + ((size_t)g * 1024 + cc0) * 384 + t0 * 16 + q0;
        bf16* gb = gy + ((size_t)cc0 * 16 + t0) * D + g * 16 + q0;
#pragma unroll
        for (int ai = 0; ai < 2; ++ai)
#pragma unroll
            for (int m = 0; m < 4; ++m) {
#pragma unroll
                for (int bj = 0; bj < 2; ++bj) {
                    const bf16* zp = zb; bf16* gp = gb; asm volatile("" : "+v"(zp), "+v"(gp));
                    const int dc = ai * 128 + m * 16;
                    const u32x4 uw = *(const u32x4*)(zp + (size_t)dc * 384 + bj * 128);
                    f32x4 v0 = acc[ai][bj][m][0], v1 = acc[ai][bj][m][1];
                    v0[0] += d0[0] * bf_lo(uw.x); v0[1] += d0[1] * bf_hi(uw.x); v0[2] += d0[2] * bf_lo(uw.y); v0[3] += d0[3] * bf_hi(uw.y);
                    v1[0] += d1[0] * bf_lo(uw.z); v1[1] += d1[1] * bf_hi(uw.z); v1[2] += d1[2] * bf_lo(uw.w); v1[3] += d1[3] * bf_hi(uw.w);
#pragma unroll
                    for (int j = 0; j < 4; ++j) { v0[j] = gelu_t(v0[j]); v1[j] = gelu_t(v1[j]); }
                    *(u32x4*)(gp + ((size_t)dc * 16 + bj * 8) * D) = pack8(v0, v1); }
                asm volatile("" ::: "memory"); }
    }
};
struct EpiG2 {
    static constexpr bool PERM = true, AFTER_DRAIN = false;
    bf16* mab;
    __device__ __forceinline__ void operator()(AccRef acc, const pg8::Unit& u, int wr, int wc, int fr, int fq) const {
        const int pn = u.pn, cb = wc * 32 + 8 * fq;
#pragma unroll
        for (int ai = 0; ai < 2; ++ai)
#pragma unroll
            for (int m = 0; m < 4; ++m) { const int row = u.pm * 256 + ai * 128 + wr * 64 + m * 16 + fr;
                if (pn < 4) {
#pragma unroll
                    for (int bj = 0; bj < 2; ++bj) { bf16* p = mab + (size_t)row * 2048 + pn * 256 + bj * 128 + cb; const u32x4 mw = *(const u32x4*)p;
                        f32x4 v0 = acc[ai][bj][m][0], v1 = acc[ai][bj][m][1];
                        v0[0] *= sigm(bf_lo(mw.x)); v0[1] *= sigm(bf_hi(mw.x)); v0[2] *= sigm(bf_lo(mw.y)); v0[3] *= sigm(bf_hi(mw.y));
                        v1[0] *= sigm(bf_lo(mw.z)); v1[1] *= sigm(bf_hi(mw.z)); v1[2] *= sigm(bf_lo(mw.w)); v1[3] *= sigm(bf_hi(mw.w));
                        *(u32x4*)p = pack8(v0, v1); }
                } else {
                    bf16* p = mab + (size_t)row * 2048 + 1024 + (pn - 4) * 128 + cb; const u32x4 mw = *(const u32x4*)p;
                    f32x4 v0 = acc[ai][0][m][0], v1 = acc[ai][0][m][1]; const f32x4 g0 = acc[ai][1][m][0], g1 = acc[ai][1][m][1];
#pragma unroll
                    for (int j = 0; j < 4; ++j) { v0[j] *= sigm(g0[j]); v1[j] *= sigm(g1[j]); }
                    v0[0] *= sigm(bf_lo(mw.x)); v0[1] *= sigm(bf_hi(mw.x)); v0[2] *= sigm(bf_lo(mw.y)); v0[3] *= sigm(bf_hi(mw.y));
                    v1[0] *= sigm(bf_lo(mw.z)); v1[1] *= sigm(bf_hi(mw.z)); v1[2] *= sigm(bf_lo(mw.w)); v1[3] *= sigm(bf_hi(mw.w));
                    *(u32x4*)p = pack8(v0, v1);
                }
                asm volatile("" ::: "memory"); }
    }
};
struct EpiRes {
    static constexpr bool PERM = false, AFTER_DRAIN = false;
    const float* xp; const float* xs;
    const float* gate;
    float* pre;
    __device__ __forceinline__ void operator()(AccRef acc, const pg8::Unit& u, int wr, int wc, int fr, int fq) const {
        const int col0 = u.pn * 256 + wc * 32 + 4 * fq;
#pragma unroll
        for (int ai = 0; ai < 2; ++ai)
#pragma unroll
            for (int m = 0; m < 4; ++m) { const int row = u.pm * 256 + ai * 128 + wr * 64 + m * 16 + fr;
                const float* xr = (row < MP ? xp + (size_t)row * D : xs + (size_t)(row - MP) * D) + col0;
                const float* gr = gate + (size_t)seq_of_row(row) * 12288 + col0;
                float* pr = pre + (size_t)row * D + col0;
#pragma unroll
                for (int bj = 0; bj < 2; ++bj)
#pragma unroll
                    for (int n = 0; n < 2; ++n) { const int o = bj * 128 + n * 16; const f32x4 xv = *(const f32x4*)(xr + o), gv = *(const f32x4*)(gr + o);
                        *(f32x4*)(pr + o) = xv * DN_ALPHA + gv * acc[ai][bj][m][n]; }
                asm volatile("" ::: "memory"); }
    }
};
struct EpiG4 {
    static constexpr bool PERM = true, AFTER_DRAIN = false;
    bf16* hf;
    __device__ __forceinline__ void operator()(AccRef acc, const pg8::Unit& u, int wr, int wc, int fr, int fq) const {
        const int cb = u.pn * 128 + wc * 32 + 8 * fq;
#pragma unroll
        for (int ai = 0; ai < 2; ++ai)
#pragma unroll
            for (int m = 0; m < 4; ++m) { const int row = u.pm * 256 + ai * 128 + wr * 64 + m * 16 + fr;
                f32x4 v0 = acc[ai][0][m][0], v1 = acc[ai][0][m][1]; const f32x4 g0 = acc[ai][1][m][0], g1 = acc[ai][1][m][1];
#pragma unroll
                for (int j = 0; j < 4; ++j) { v0[j] = silu_f(v0[j]) * g0[j]; v1[j] = silu_f(v1[j]) * g1[j]; }
                *(u32x4*)(hf + (size_t)row * DFF + cb) = pack8(v0, v1);
                asm volatile("" ::: "memory"); }
    }
};

#define XB_TMO      128
#define XB_XCNT(j)  (256  + 64 * (j))
#define XB_XSUB(j)  (1280 + 64 * (j))
#define XB_XGEN(j)  (2304 + 64 * (j))
#define XB_TOP      3328
#define XB_TOPGEN   3392
#define XCD_BAR_WORDS 3456
#define XB_SPIN_CAP (1u << 20)
__device__ __forceinline__ unsigned xb_ld(unsigned* p)              { return __hip_atomic_load(p, __ATOMIC_RELAXED, __HIP_MEMORY_SCOPE_AGENT); }
__device__ __forceinline__ unsigned xb_add(unsigned* p, unsigned v) { return __hip_atomic_fetch_add(p, v, __ATOMIC_RELAXED, __HIP_MEMORY_SCOPE_AGENT); }
__device__ __forceinline__ unsigned xb_xcc_id() { return (unsigned)__builtin_amdgcn_s_getreg((3 << 11) | 20) & 0xFu; }
#define XB_SPIN(cond, bar) do { unsigned _sp = 0; while (cond) { __builtin_amdgcn_s_sleep(1); \
    if ((++_sp & 255u) == 0u) { if (xb_ld(&(bar)[XB_TMO])) break; if (_sp > XB_SPIN_CAP) { atomicAdd(&(bar)[XB_TMO], 1u); break; } } } } while (0)
struct XcdBarrier { unsigned* bar; unsigned x; volatile LAS unsigned* st; };
__device__ __forceinline__ XcdBarrier xcd_barrier_post(unsigned* bar, volatile LAS unsigned* st) {
    XcdBarrier b; b.bar = bar; b.x = xb_xcc_id(); b.st = st;
    if (threadIdx.x == 0) (void)xb_add(&bar[XB_XCNT(b.x)], 1u);
    return b;
}
__device__ __forceinline__ void xcd_barrier_complete(unsigned* bar, unsigned x, unsigned& nloc, unsigned& nx) {
    const unsigned G = gridDim.x * gridDim.y * gridDim.z;
    unsigned sum, cnt, mine, sp = 0u;
    for (;;) {
        sum = 0u; cnt = 0u; mine = 0u;
#pragma unroll
        for (unsigned j = 0; j < 16; ++j) { const unsigned c = xb_ld(&bar[XB_XCNT(j)]); sum += c; cnt += (c > 0u) ? 1u : 0u; mine = (j == x) ? c : mine; }
        if (sum == G) break;
        __builtin_amdgcn_s_sleep(1);
        if ((++sp & 255u) == 0u) { if (xb_ld(&bar[XB_TMO])) break; if (sp > XB_SPIN_CAP) { atomicAdd(&bar[XB_TMO], 1u); break; } }
    }
    nloc = mine > 0u ? mine : 1u; nx = cnt > 0u ? cnt : 1u;
}
__device__ __forceinline__ void xcd_barrier(const XcdBarrier& b) {
    asm volatile("s_waitcnt vmcnt(0)" ::: "memory");
    __syncthreads();
    if (threadIdx.x == 0) {
        unsigned* bar = b.bar;
        __builtin_amdgcn_s_waitcnt(0);
        unsigned nloc = b.st[0], nx = b.st[1];
        if (nloc == 0u) { xcd_barrier_complete(bar, b.x, nloc, nx); b.st[0] = nloc; b.st[1] = nx; }
        const unsigned old = xb_add(&bar[XB_XSUB(b.x)], 1u);
        const unsigned gen = old / nloc;
        if (old + 1u == (gen + 1u) * nloc) {
            __builtin_amdgcn_fence(__ATOMIC_RELEASE, "agent");
            asm volatile("s_waitcnt vmcnt(0)" ::: "memory");
            const unsigned og = xb_add(&bar[XB_TOP], 1u);
            const unsigned tg = og / nx;
            if (og + 1u == (tg + 1u) * nx) xb_add(&bar[XB_TOPGEN], 1u);
            else XB_SPIN(xb_ld(&bar[XB_TOPGEN]) == tg, bar);
            __builtin_amdgcn_fence(__ATOMIC_ACQUIRE, "agent");
            xb_add(&bar[XB_XGEN(b.x)], 1u);
            asm volatile("s_waitcnt vmcnt(0)" ::: "memory");
        } else {
            XB_SPIN(xb_ld(&bar[XB_XGEN(b.x)]) == gen, bar);
            __builtin_amdgcn_fence(__ATOMIC_ACQUIRE, "agent");
            asm volatile("s_waitcnt vmcnt(0)" ::: "memory");
        }
    }
    __syncthreads();
}

struct Args { const float* in[34]; float* out; unsigned char* ws; int ph_lo, ph_hi; };
typedef __attribute__((address_space(4))) const Args CArgs;
enum { I_XP = 0, I_XS, I_CP, I_CS, I_SLH, I_SLC, I_SRE, I_SIM, I_WADA, I_BADA, I_WIN, I_BIN, I_WCONV, I_BCONV, I_WLG, I_BLG, I_LAM, I_WLO, I_ARE, I_AIM, I_LDT, I_BRE, I_BIM, I_CRE, I_CIM, I_SD, I_WGLU, I_WOUT, I_LN1G, I_LN1B, I_WUP, I_WDN, I_LN2G, I_LN2B };

__device__ __forceinline__ void transpose_item(const float* W, int K, int N, bf16* dst, int ldd, int mode, int halfc, bool dup, LAS float* scr, int item, int lane) {
    const int nblk = N / 32, kb = item / nblk, nb = item % nblk, k0 = 64 * kb, n0 = 32 * nb;
#pragma unroll 8
    for (int i = 0; i < 32; ++i) { const int kk = 2 * i + (lane >> 5); scr[kk * 33 + (lane & 31)] = W[(size_t)(k0 + kk) * N + n0 + (lane & 31)]; }
    LDS_WAIT(); asm volatile("" ::: "memory");
    int d0 = n0;
    if (mode == 1) { if (n0 < halfc) d0 = 256 * (n0 >> 7) + (n0 & 127); else { const int n1 = n0 - halfc; d0 = 256 * (n1 >> 7) + 128 + (n1 & 127); } }
    const int c = lane & 7;
#pragma unroll
    for (int j = 0; j < 4; ++j) { const int n = (lane >> 3) + 8 * j; const LAS float* s = scr + (8 * c) * 33 + n;
        u32x4 o; o.x = cvt_pk_bf16(s[0 * 33], s[1 * 33]); o.y = cvt_pk_bf16(s[2 * 33], s[3 * 33]); o.z = cvt_pk_bf16(s[4 * 33], s[5 * 33]); o.w = cvt_pk_bf16(s[6 * 33], s[7 * 33]);
        bf16* p = dst + (size_t)(d0 + n) * ldd + k0 + 8 * c;
        *(u32x4*)p = o; if (dup) *(u32x4*)(p + K) = o; }
    LDS_WAIT(); asm volatile("" ::: "memory");
}

__device__ __forceinline__ void convert_main(CArgs* a, int l, bool with_ada, LAS unsigned char* lds, int gw, int NGW, int wave, int lane) {
    LAS float* scr = (LAS float*)(lds + wave * 16384);
    unsigned char* ws = a->ws;
    constexpr int I0 = 16 * 160, I1 = 16 * 32, I2 = 16 * 64, I3 = 16 * 32, I4 = 16 * 192;
    const int total = I0 + I1 + I2 + I3 + (with_ada ? 2 * I4 : 0);
    for (int it = gw; it < total; it += NGW) {
        int r = it;
        if (r < I0) { transpose_item(a->in[I_WIN] + (size_t)l * D * NIN, D, NIN, (bf16*)(ws + WS_WIN), D, 0, 0, false, scr, r, lane); continue; } r -= I0;
        if (r < I1) { transpose_item(a->in[I_WLO] + (size_t)l * D * D, D, D, (bf16*)(ws + WS_W2), D, 0, 0, false, scr, r, lane); continue; } r -= I1;
        if (r < I2) { transpose_item(a->in[I_WGLU] + (size_t)l * D * 2048, D, 2048, (bf16*)(ws + WS_W2) + (size_t)1024 * D, D, 1, 1024, false, scr, r, lane); continue; } r -= I2;
        if (r < I3) { transpose_item(a->in[I_WOUT] + (size_t)l * D * D, D, D, (bf16*)(ws + WS_WOUT2), 2048, 0, 0, true, scr, r, lane); continue; } r -= I3;
        if (r < I4) { transpose_item(a->in[I_WADA], D, NADA, (bf16*)(ws + WS_WADA), D, 0, 0, false, scr, r, lane); continue; } r -= I4;
        transpose_item(a->in[I_WADA] + (size_t)D * NADA, D, NADA, (bf16*)(ws + WS_WADA) + (size_t)NADA * D, D, 0, 0, false, scr, r, lane);
    }
}
__device__ __forceinline__ void convert_ffn(CArgs* a, int l, LAS unsigned char* lds, int gw, int NGW, int wave, int lane) {
    LAS float* scr = (LAS float*)(lds + wave * 16384);
    unsigned char* ws = a->ws;
    constexpr int I0 = 16 * 176, I1 = 44 * 32;
    for (int it = gw; it < I0 + I1; it += NGW) {
        if (it < I0) transpose_item(a->in[I_WUP] + (size_t)l * D * 2 * DFF, D, 2 * DFF, (bf16*)(ws + WS_WUP), D, 1, DFF, false, scr, it, lane);
        else transpose_item(a->in[I_WDN] + (size_t)l * DFF * D, DFF, D, (bf16*)(ws + WS_WDN), DFF, 0, 0, false, scr, it - I0, lane);
    }
}

__device__ __forceinline__ void s5_tables(CArgs* a, int l, int g, LAS unsigned char* lds, int tid) {
    LAS float* Apr = (LAS float*)lds;
    LAS float* Api = Apr + 17 * 64;
    LAS float* Bbr = Api + 17 * 64;
    LAS float* Bbi = Bbr + 1024;
    LAS float* Cr = Bbi + 1024;
    LAS float* Ci = Cr + 1024;
    LAS float* Kl = Ci + 1024;
    unsigned char* ws = a->ws;
    float* aux = (float*)(ws + WS_S5AUX);
    const float* are = a->in[I_ARE] + (size_t)l * 4096 + g * 64; const float* aim = a->in[I_AIM] + (size_t)l * 4096 + g * 64;
    const double dt = exp((double)a->in[I_LDT][l * 64 + g]);
    for (int e = tid; e < 1024; e += 512) {
        const int p = e >> 4, q = e & 15;
        const double ar = are[p], ai = aim[p];
        const double mag = exp(ar * dt), th = ai * dt, abr = mag * cos(th), abi = mag * sin(th);
        const double nr = abr - 1.0, ni = abi, den = ar * ar + ai * ai;
        const double fr = (nr * ar + ni * ai) / den, fi = (ni * ar - nr * ai) / den;
        const double br = a->in[I_BRE][((size_t)l * 64 + g) * 1024 + e], bi = a->in[I_BIM][((size_t)l * 64 + g) * 1024 + e];
        const float bbr = (float)(fr * br - fi * bi), bbi = (float)(fr * bi + fi * br);
        Bbr[e] = bbr; Bbi[e] = bbi;
        aux[16384 + (size_t)g * 1024 + e] = bbr; aux[16384 + 65536 + (size_t)g * 1024 + e] = bbi;
        Cr[q * 64 + p] = a->in[I_CRE][((size_t)l * 64 + g) * 1024 + q * 64 + p]; Ci[q * 64 + p] = a->in[I_CIM][((size_t)l * 64 + g) * 1024 + q * 64 + p];
        if (q == 0) {
            double pr = 1.0, pi = 0.0;
            for (int k = 0; k <= 16; ++k) { Apr[k * 64 + p] = (float)pr; Api[k * 64 + p] = (float)pi; const double t = pr * abr - pi * abi; pi = pr * abi + pi * abr; pr = t; }
            aux[g * 64 + p] = (float)abr; aux[4096 + g * 64 + p] = (float)abi;
            aux[8192 + g * 64 + p] = Apr[16 * 64 + p]; aux[12288 + g * 64 + p] = Api[16 * 64 + p];
        }
    }
    __syncthreads();
    for (int e = tid; e < 4096; e += 512) {
        const int k = e >> 8, q = (e >> 4) & 15, qq = e & 15; float s = 0.f;
        for (int p = 0; p < 64; ++p) { const float abr_ = Apr[k * 64 + p] * Bbr[p * 16 + qq] - Api[k * 64 + p] * Bbi[p * 16 + qq], abi_ = Apr[k * 64 + p] * Bbi[p * 16 + qq] + Api[k * 64 + p] * Bbr[p * 16 + qq];
            s += Cr[q * 64 + p] * abr_ - Ci[q * 64 + p] * abi_; }
        Kl[e] = s;
    }
    __syncthreads();
    bf16* tw = (bf16*)(ws + WS_TW) + (size_t)g * 256 * 384;
    for (int ch = tid; ch < 256 * 48; ch += 512) {
        const int n = ch / 48, k0 = (ch % 48) * 8, t = n >> 4, q = n & 15; float v[8];
        if (k0 < 256) { const int s = k0 >> 4, qq0 = k0 & 15;
#pragma unroll
            for (int j = 0; j < 8; ++j) v[j] = (t >= s) ? Kl[((t - s) * 16 + q) * 16 + qq0 + j] : 0.f;
        } else { const int j0 = k0 - 256;
#pragma unroll
            for (int j = 0; j < 8; ++j) { const int jj = j0 + j, p = jj & 63; const float cr = Cr[q * 64 + p], ci = Ci[q * 64 + p], pr = Apr[(t + 1) * 64 + p], pi = Api[(t + 1) * 64 + p];
                v[j] = (jj < 64) ? (cr * pr - ci * pi) : -(cr * pi + ci * pr); } }
        u32x4 o; o.x = cvt_pk_bf16(v[0], v[1]); o.y = cvt_pk_bf16(v[2], v[3]); o.z = cvt_pk_bf16(v[4], v[5]); o.w = cvt_pk_bf16(v[6], v[7]);
        *(u32x4*)(tw + (size_t)n * 384 + k0) = o;
    }
    bf16* wst = (bf16*)(ws + WS_WST) + (size_t)g * 256 * 256;
    for (int ch = tid; ch < 256 * 32; ch += 512) {
        const int n = ch >> 5, k0 = (ch & 31) * 8, s = k0 >> 4, qq0 = k0 & 15, p = n & 63; float v[8];
#pragma unroll
        for (int j = 0; j < 8; ++j) { const float pr = Apr[(15 - s) * 64 + p], pi = Api[(15 - s) * 64 + p], br = Bbr[p * 16 + qq0 + j], bi = Bbi[p * 16 + qq0 + j];
            v[j] = (n < 64) ? (pr * br - pi * bi) : ((n < 128) ? (pr * bi + pi * br) : 0.f); }
        u32x4 o; o.x = cvt_pk_bf16(v[0], v[1]); o.y = cvt_pk_bf16(v[2], v[3]); o.z = cvt_pk_bf16(v[4], v[5]); o.w = cvt_pk_bf16(v[6], v[7]);
        *(u32x4*)(wst + (size_t)n * 256 + k0) = o;
    }
    __syncthreads();
}

__device__ __forceinline__ void row_phase(int mode, const float* src_p, const float* src_s, float* xout, bf16* uout, const float* gam, const float* bet,
                                          const float* ada_sh, const float* ada_sc, bool write_u, int gw, int NGW, int lane) {
    for (int row = gw; row < M; row += NGW) {
        const float* sr = (row < MP ? src_p + (size_t)row * D : src_s + (size_t)(row - MP) * D);
        f32x4 v[4];
#pragma unroll
        for (int j = 0; j < 4; ++j) v[j] = *(const f32x4*)(sr + 4 * lane + 256 * j);
        if (mode == 1) {
            float s = 0.f;
#pragma unroll
            for (int j = 0; j < 4; ++j) s += (v[j][0] + v[j][1]) + (v[j][2] + v[j][3]);
            const float mean = wave_sum(s, lane) * (1.f / D); float s2 = 0.f;
#pragma unroll
            for (int j = 0; j < 4; ++j) { v[j] = v[j] - mean; s2 += (v[j][0] * v[j][0] + v[j][1] * v[j][1]) + (v[j][2] * v[j][2] + v[j][3] * v[j][3]); }
            const float rstd = 1.f / sqrtf(wave_sum(s2, lane) * (1.f / D) + LN_EPS);
#pragma unroll
            for (int j = 0; j < 4; ++j) { const f32x4 gv = *(const f32x4*)(gam + 4 * lane + 256 * j), bv = *(const f32x4*)(bet + 4 * lane + 256 * j);
                v[j] = v[j] * rstd * gv + bv; *(f32x4*)(xout + (size_t)row * D + 4 * lane + 256 * j) = v[j]; }
        }
        if (write_u) {
            const int seq = seq_of_row(row);
#pragma unroll
            for (int j = 0; j < 4; ++j) { const f32x4 sc = *(const f32x4*)(ada_sc + (size_t)seq * 12288 + 4 * lane + 256 * j), sh = *(const f32x4*)(ada_sh + (size_t)seq * 12288 + 4 * lane + 256 * j);
                const f32x4 uu = v[j] * (sc + 1.f) + sh; u32x2 w; w.x = cvt_pk_bf16(uu[0], uu[1]); w.y = cvt_pk_bf16(uu[2], uu[3]);
                *(u32x2*)(uout + (size_t)row * D + 4 * lane + 256 * j) = w; }
        }
    }
}

constexpr int L_ZL = 0, L_VB = 16896, L_AA = 35328, L_BB = 53760, L_PS = 72192, L_BS = 74240, L_HC = 76288;
__device__ __forceinline__ float neg_expm1_2x(float la, float av) {
    const float x = 2.f * la;
    float p = 1.f / 720.f; p = p * x + 1.f / 120.f; p = p * x + 1.f / 24.f; p = p * x + 1.f / 6.f; p = p * x + 0.5f; p = p * x + 1.f;
    return x > -0.25f ? -x * p : 1.f - av * av;
}
#define LRU_BAR() do { asm volatile("s_waitcnt lgkmcnt(0)" ::: "memory"); __builtin_amdgcn_s_barrier(); asm volatile("" ::: "memory"); } while (0)
template <bool PROMPT>
__device__ __forceinline__ void lru_tile(CArgs* a, int l, int tb, int h, int half, const bf16* zl, const bf16* zg, bf16* hg, LAS unsigned char* lds, int tid) {
    const int wave = tid >> 6, lane = tid & 63;
    LAS bf16* ZL = (LAS bf16*)(lds + L_ZL); LAS bf16* VB = (LAS bf16*)(lds + L_VB);
    LAS float* AA = (LAS float*)(lds + L_AA); LAS float* BB = (LAS float*)(lds + L_BB);
    LAS float* PS = (LAS float*)(lds + L_PS); LAS float* BS = (LAS float*)(lds + L_BS); LAS float* HC = (LAS float*)(lds + L_HC);
    const int ch0 = h * 64, cA = ch0 + half * 32;
    bf16x8 Bw[4][2];
    {
        const float* wg = a->in[I_WLG] + (size_t)l * 2 * 16 * 4096;
#pragma unroll
        for (int nf = 0; nf < 4; ++nf)
#pragma unroll
            for (int ks = 0; ks < 2; ++ks) { const int gate = nf >> 1, j = half * 32 + 16 * (nf & 1) + (lane & 15), k0 = 32 * ks + 8 * (lane >> 4);
                const float* p = wg + ((size_t)(gate * 16 + h) * 64 + k0) * 64 + j; u32x4 w;
                w.x = cvt_pk_bf16(p[0], p[64]); w.y = cvt_pk_bf16(p[128], p[192]); w.z = cvt_pk_bf16(p[256], p[320]); w.w = cvt_pk_bf16(p[384], p[448]);
                Bw[nf][ks] = __builtin_bit_cast(bf16x8, w); }
    }
    float bg0[2], bg1[2], nl8[2];
#pragma unroll
    for (int nf = 0; nf < 2; ++nf) { const int c = cA + 16 * nf + (lane & 15);
        bg0[nf] = a->in[I_BLG][(size_t)l * 2048 + c]; bg1[nf] = a->in[I_BLG][(size_t)l * 2048 + 1024 + c];
        const float x = -a->in[I_LAM][(size_t)l * 1024 + c];
        nl8[nf] = -8.f * ((x > 0.f ? x : 0.f) + log1pf(__expf(-fabsf(x)))); }
    const int c8 = tid & 7, cg = ch0 + c8 * 8;
    f32x4 cw[4][2], cb[2];
#pragma unroll
    for (int k = 0; k < 4; ++k) { cw[k][0] = *(const f32x4*)(a->in[I_WCONV] + ((size_t)l * 4 + k) * 1024 + cg); cw[k][1] = *(const f32x4*)(a->in[I_WCONV] + ((size_t)l * 4 + k) * 1024 + cg + 4); }
    cb[0] = *(const f32x4*)(a->in[I_BCONV] + (size_t)l * 1024 + cg); cb[1] = *(const f32x4*)(a->in[I_BCONV] + (size_t)l * 1024 + cg + 4);
    if (tid < 64) HC[tid] = 0.f;
    const int nchunk = PROMPT ? 16 : 1;
    const int rowbase0 = PROMPT ? tb * TSEQ : MP + tb * 128;
    const int sc = tid & 31, ss = tid >> 5;
    const int ot = tid >> 2, opc = tid & 3;
    float hlast = 0.f;
    u32x4 zq[3], zgq;
#define LRU_PREFETCH(ck_) do { const int rb_ = rowbase0 + (ck_) * 128; \
        _Pragma("unroll") for (int i_ = 0; i_ < 3; ++i_) { const int pc_ = tid + 512 * i_, r_ = pc_ >> 3, c_ = pc_ & 7; zq[i_] = (u32x4){0u, 0u, 0u, 0u}; \
            const bool ok_ = (pc_ < 131 * 8) && (PROMPT ? ((ck_) > 0 || r_ >= 3) : (r_ >= 3)); \
            if (ok_) zq[i_] = *(const u32x4*)(zl + (size_t)(rb_ - 3 + r_) * D + ch0 + c_ * 8); } \
        zgq = *(const u32x4*)(zg + (size_t)(rb_ + ot) * D + cA + opc * 8); } while (0)
    LRU_PREFETCH(0);
    for (int ck = 0; ck < nchunk; ++ck) {
        const int rowbase = rowbase0 + ck * 128;
        LRU_BAR();
#pragma unroll
        for (int i = 0; i < 3; ++i) { const int pc = tid + 512 * i; if (pc < 131 * 8) *(LAS u32x4*)(ZL + (pc >> 3) * 64 + (pc & 7) * 8) = zq[i]; }
        const u32x4 zgc = zgq;
        if (ck + 1 < nchunk) LRU_PREFETCH(ck + 1);
        LRU_BAR();
#pragma unroll
        for (int i2 = 0; i2 < 2; ++i2) { const int t = (tid >> 3) + 64 * i2;
            f32x4 v0 = cb[0], v1 = cb[1];
#pragma unroll
            for (int k = 0; k < 4; ++k) {
                f32x4 x0, x1;
                bool from_state = false; int idx = 0;
                if (!PROMPT) { idx = (t & 3) + k; from_state = idx < 3; }
                if (from_state) { const int seq = tb * 32 + (t >> 2); const float* sp = a->in[I_SLC] + (((size_t)l * 128 + seq) * 3 + idx) * 1024 + cg; x0 = *(const f32x4*)sp; x1 = *(const f32x4*)(sp + 4); }
                else { const u32x4 w = *(const LAS u32x4*)(ZL + (t + k) * 64 + c8 * 8);
                    x0 = (f32x4){bf_lo(w.x), bf_hi(w.x), bf_lo(w.y), bf_hi(w.y)}; x1 = (f32x4){bf_lo(w.z), bf_hi(w.z), bf_lo(w.w), bf_hi(w.w)}; }
                v0 += cw[k][0] * x0; v1 += cw[k][1] * x1;
            }
            if ((c8 >> 2) == half) { *(LAS f32x4*)(BB + t * 36 + (c8 & 3) * 8) = v0; *(LAS f32x4*)(BB + t * 36 + (c8 & 3) * 8 + 4) = v1; }
            *(LAS u32x4*)(VB + t * 72 + c8 * 8) = pack8(v0, v1); }
        LRU_BAR();
        {
            f32x4 Dg[4];
#pragma unroll
            for (int nf = 0; nf < 4; ++nf) Dg[nf] = (f32x4){0.f, 0.f, 0.f, 0.f};
#pragma unroll
            for (int ks = 0; ks < 2; ++ks) { const bf16x8 af = *(const LAS bf16x8*)(VB + (16 * wave + (lane & 15)) * 72 + 32 * ks + 8 * (lane >> 4));
#pragma unroll
                for (int nf = 0; nf < 4; ++nf) Dg[nf] = __builtin_amdgcn_mfma_f32_16x16x32_bf16(af, Bw[nf][ks], Dg[nf], 0, 0, 0); }
#pragma unroll
            for (int nf = 0; nf < 2; ++nf)
#pragma unroll
                for (int rg = 0; rg < 4; ++rg) { const int t = 16 * wave + 4 * (lane >> 4) + rg, c = 16 * nf + (lane & 15);
                    const float r = sigm(Dg[nf][rg] + bg0[nf]), ig = sigm(Dg[nf + 2][rg] + bg1[nf]);
                    const float la = r * nl8[nf]; const float av = __expf(la); const float m = neg_expm1_2x(la, av);
                    const float v = BB[t * 36 + c];
                    AA[t * 36 + c] = av; BB[t * 36 + c] = __builtin_amdgcn_sqrtf(m) * (ig * v); }
        }
        LRU_BAR();
        if (PROMPT) {
            float P = 1.f, Bv = 0.f;
#pragma unroll
            for (int j = 0; j < 8; ++j) { const int t = 8 * ss + j; const float av = AA[t * 36 + sc], bv = BB[t * 36 + sc]; Bv = av * Bv + bv; P *= av; BB[t * 36 + sc] = Bv; AA[t * 36 + sc] = P; }
            PS[ss * 32 + sc] = P; BS[ss * 32 + sc] = Bv;
            LRU_BAR();
            float carry = HC[(ck & 1) * 32 + sc];
            for (int s2 = 0; s2 < ss; ++s2) carry = PS[s2 * 32 + sc] * carry + BS[s2 * 32 + sc];
            if (ss == 15) { hlast = P * carry + Bv; HC[((ck + 1) & 1) * 32 + sc] = hlast; }
#pragma unroll
            for (int j = 0; j < 8; ++j) { const int t = 8 * ss + j; BB[t * 36 + sc] += AA[t * 36 + sc] * carry; }
        } else {
            float hv = 0.f;
#pragma unroll
            for (int j = 0; j < 8; ++j) { const int t = 8 * ss + j; const int seq = tb * 32 + (t >> 2);
                if ((j & 3) == 0) hv = a->in[I_SLH][((size_t)l * 128 + seq) * 1024 + cA + sc];
                hv = AA[t * 36 + sc] * hv + BB[t * 36 + sc]; BB[t * 36 + sc] = hv;
                if ((j & 3) == 3) a->out[O_HS + ((size_t)l * 128 + seq) * 1024 + cA + sc] = hv; }
        }
        LRU_BAR();
        {
            const f32x4 h0 = *(const LAS f32x4*)(BB + ot * 36 + opc * 8), h1 = *(const LAS f32x4*)(BB + ot * 36 + opc * 8 + 4);
            f32x4 o0, o1;
            o0[0] = h0[0] * gelu_t(bf_lo(zgc.x)); o0[1] = h0[1] * gelu_t(bf_hi(zgc.x)); o0[2] = h0[2] * gelu_t(bf_lo(zgc.y)); o0[3] = h0[3] * gelu_t(bf_hi(zgc.y));
            o1[0] = h1[0] * gelu_t(bf_lo(zgc.z)); o1[1] = h1[1] * gelu_t(bf_hi(zgc.z)); o1[2] = h1[2] * gelu_t(bf_lo(zgc.w)); o1[3] = h1[3] * gelu_t(bf_hi(zgc.w));
            *(u32x4*)(hg + (size_t)(rowbase + ot) * D + cA + opc * 8) = pack8(o0, o1);
        }
    }
#undef LRU_PREFETCH
    if (PROMPT) {
        if (ss == 15) a->out[O_HP + ((size_t)l * 8 + tb) * 1024 + cA + sc] = hlast;
        if (tid < 96) { const int k = tid >> 5, c = tid & 31; a->out[O_CP + (((size_t)l * 8 + tb) * 3 + k) * 1024 + cA + c] = bf2f(zl[(size_t)(tb * TSEQ + TSEQ - 3 + k) * D + cA + c]); }
    } else {
        for (int e = tid; e < 32 * 3 * 32; e += 512) { const int c = e & 31, k = (e >> 5) % 3, sq = e / 96; const int seq = tb * 32 + sq;
            a->out[O_CS + (((size_t)l * 128 + seq) * 3 + k) * 1024 + cA + c] = bf2f(zl[(size_t)(MP + seq * 4 + 1 + k) * D + cA + c]); }
    }
    __syncthreads();
}

__device__ __forceinline__ void s5_sample_item(CArgs* a, int l, int seq, int g, const bf16* zs5s, bf16* gy, LAS float* xs  , int lane) {
    const float* aux = (const float*)(a->ws + WS_S5AUX);
    const int p = lane;
    const float ar = aux[g * 64 + p], ai = aux[4096 + g * 64 + p];
    float bbr[16], bbi[16];
#pragma unroll
    for (int q4 = 0; q4 < 4; ++q4) { const f32x4 r4 = *(const f32x4*)(aux + 16384 + (size_t)g * 1024 + p * 16 + q4 * 4), i4 = *(const f32x4*)(aux + 16384 + 65536 + (size_t)g * 1024 + p * 16 + q4 * 4);
#pragma unroll
        for (int j = 0; j < 4; ++j) { bbr[q4 * 4 + j] = r4[j]; bbi[q4 * 4 + j] = i4[j]; } }
    float xr = a->in[I_SRE][(((size_t)l * 128 + seq) * 64 + g) * 64 + p], xi = a->in[I_SIM][(((size_t)l * 128 + seq) * 64 + g) * 64 + p];
#pragma unroll
    for (int t = 0; t < 4; ++t) {
        const bf16* up = zs5s + (size_t)(seq * 4 + t) * D + g * 16;
        const u32x4 w0 = *(const u32x4*)up, w1 = *(const u32x4*)(up + 8);
        float uu[16] = {bf_lo(w0.x), bf_hi(w0.x), bf_lo(w0.y), bf_hi(w0.y), bf_lo(w0.z), bf_hi(w0.z), bf_lo(w0.w), bf_hi(w0.w), bf_lo(w1.x), bf_hi(w1.x), bf_lo(w1.y), bf_hi(w1.y), bf_lo(w1.z), bf_hi(w1.z), bf_lo(w1.w), bf_hi(w1.w)};
        float br = 0.f, bi = 0.f;
#pragma unroll
        for (int q = 0; q < 16; ++q) { br += bbr[q] * uu[q]; bi += bbi[q] * uu[q]; }
        const float nr = ar * xr - ai * xi + br, ni = ar * xi + ai * xr + bi; xr = nr; xi = ni;
        xs[(t * 2 + 0) * 64 + p] = xr; xs[(t * 2 + 1) * 64 + p] = xi;
    }
    a->out[O_RS + (((size_t)l * 128 + seq) * 64 + g) * 64 + p] = xr; a->out[O_IS + (((size_t)l * 128 + seq) * 64 + g) * 64 + p] = xi;
    LDS_WAIT(); asm volatile("" ::: "memory");
    const int t = lane >> 4, q = lane & 15;
    const float* cr = a->in[I_CRE] + (((size_t)l * 64 + g) * 16 + q) * 64; const float* ci = a->in[I_CIM] + (((size_t)l * 64 + g) * 16 + q) * 64;
    float y = 0.f;
#pragma unroll 4
    for (int p4 = 0; p4 < 16; ++p4) { const f32x4 c4 = *(const f32x4*)(cr + p4 * 4), d4 = *(const f32x4*)(ci + p4 * 4);
        const f32x4 r4 = *(const LAS f32x4*)(xs + (t * 2 + 0) * 64 + p4 * 4), i4 = *(const LAS f32x4*)(xs + (t * 2 + 1) * 64 + p4 * 4);
        y += (c4[0] * r4[0] + c4[1] * r4[1]) + (c4[2] * r4[2] + c4[3] * r4[3]) - ((d4[0] * i4[0] + d4[1] * i4[1]) + (d4[2] * i4[2] + d4[3] * i4[3])); }
    const float uq = bf2f(zs5s[(size_t)(seq * 4 + t) * D + g * 16 + q]);
    y += a->in[I_SD][(size_t)l * 1024 + g * 16 + q] * uq;
    gy[(size_t)(MP + seq * 4 + t) * D + g * 16 + q] = f2bf(gelu_t(y));
    LDS_WAIT(); asm volatile("" ::: "memory");
}

constexpr int N_PHASES = 3 + 9 * 2;
__device__ __forceinline__ void phase_body(const int ph, LAS unsigned char* lds, const int G, const int bx) {
        int tid = threadIdx.x; asm volatile("" : "+v"(tid));
        CArgs* ap = (CArgs*)__builtin_amdgcn_kernarg_segment_ptr(); asm volatile("" : "+s"(ap));
        unsigned char* ws = ap->ws;
        const int lane = tid & 63, wave = __builtin_amdgcn_readfirstlane(tid >> 6);
        const int gw = bx * NWAVES + wave, NGW = G * NWAVES;
        float* ada = (float*)(ws + WS_ADA);
        bf16* T1 = (bf16*)(ws + WS_T1); bf16* T2 = (bf16*)(ws + WS_T2); bf16* T3 = (bf16*)(ws + WS_T3);
        bf16* ZS = (bf16*)(ws + WS_T4); bf16* MAB = (bf16*)(ws + WS_T5); bf16* ZS5S = (bf16*)(ws + WS_ZS5S); bf16* HF = (bf16*)(ws + WS_HF);
        if (ph == 0) { if constexpr (PH_ON(0)) {
            convert_main(ap, 0, true, lds, gw, NGW, wave, lane);
            bf16* SC = (bf16*)(ws + WS_SC);
            for (int e = bx * 512 + tid; e < 256 * D / 4; e += G * 512) { const int row = e >> 8, c4 = (e & 255) * 4; u32x2 w = (u32x2){0u, 0u};
                if (row < NSEQ) { const f32x4 cv = *(const f32x4*)((row < 8 ? ap->in[I_CP] + (size_t)row * D : ap->in[I_CS] + (size_t)(row - 8) * D) + c4);
                    w.x = cvt_pk_bf16(silu_f(cv[0]), silu_f(cv[1])); w.y = cvt_pk_bf16(silu_f(cv[2]), silu_f(cv[3])); }
                *(u32x2*)(SC + (size_t)row * D + c4) = w; }
            __syncthreads();
            if (bx < 64) s5_tables(ap, 0, bx, lds, tid); }
        } else if (ph == 1) { if constexpr (PH_ON(1)) {
            pg8::Gemm g{D, D, D}; pg8::SchedStd S; S.o.init(1, 48, G, bx); S.A0 = S.A1 = (const char*)(ws + WS_SC); S.asplit = 1 << 30; S.at = 0; S.bt = (size_t)256 * D * 2; S.B0 = (const char*)(ws + WS_WADA);
            EpiAda E{ada, ap->in[I_BADA]};
            pg8::gemm_phase<EpiAda, pg8::SchedStd, false, true>(lds, g, S, E, tid); }
        } else if (ph == 2) { if constexpr (PH_ON(2)) {
            row_phase(0, ap->in[I_XP], ap->in[I_XS], nullptr, T1, nullptr, nullptr, ada + 0 * 1024, ada + 1 * 1024, true, gw, NGW, lane); }
        } else {
            const int l = (ph - 3) / 9, sp = (ph - 3) % 9;
            bf16* Ua = (l & 1) ? T3 : T1;
            bf16* Ub = (l & 1) ? T1 : T3;
            float* PRE = (float*)((l & 1) ? T2 : T1);
            float* adl = ada + (size_t)l * NADA;
            const float* xp = l == 0 ? ap->in[I_XP] : ap->out + O_Y; const float* xs = l == 0 ? ap->in[I_XS] : ap->out + O_Y + (size_t)MP * D;
            float* yo = ap->out + O_Y;
            if (sp == 0) { if constexpr (PH_ON(3)) {
                pg8::Gemm g{D, D, D}; pg8::SchedStd S; S.o.init(66, 20, G, bx); S.A0 = S.A1 = (const char*)Ua; S.asplit = 1 << 30; S.at = (size_t)256 * D * 2; S.bt = (size_t)256 * D * 2; S.B0 = (const char*)(ws + WS_WIN);
                EpiG1 E{T2, Ub, ZS, ZS5S, MAB, ap->in[I_BIN] + (size_t)l * NIN};
                pg8::gemm_phase<EpiG1, pg8::SchedStd, true, true>(lds, g, S, E, tid); }
            } else if (sp == 1) { if constexpr (PH_ON(4)) {
                {
                    pg8::Gemm g{384, 256, 256};
                    const float* aux = (const float*)(ws + WS_S5AUX);
                    for (int u0 = bx; u0 < 256; u0 += G) {
                        pg8::SchedS5 S{u0, 1, (const char*)ZS, (const char*)(ws + WS_WST), (size_t)256 * 384 * 2, (size_t)256 * 256 * 2};
                        EpiS5A E{ZS, aux + 8192, aux + 12288, ap->out + O_RP + (size_t)l * 8 * 4096, ap->out + O_IP + (size_t)l * 8 * 4096};
                        pg8::gemm_phase<EpiS5A, pg8::SchedS5, false, true>(lds, g, S, E, tid);
                    }
                }
                asm volatile("" : "+v"(tid));
                for (int tl = bx; tl < 256; tl += G) lru_tile<true>(ap, l, tl >> 5, (tl >> 1) & 15, tl & 1, T2, Ub, Ua, lds, tid);
                asm volatile("" : "+v"(tid));
                for (int tl = bx; tl < 128; tl += G) lru_tile<false>(ap, l, tl >> 5, (tl >> 1) & 15, tl & 1, T2, Ub, Ua, lds, tid);
                }
            } else if (sp == 2) { if constexpr (PH_ON(5)) {
                pg8::Gemm g{384, 384, 384};
                for (int u0 = bx; u0 < 256; u0 += G) {
                    pg8::SchedS5 S{u0, 1, (const char*)ZS, (const char*)(ws + WS_TW), (size_t)256 * 384 * 2, (size_t)256 * 384 * 2};
                    EpiS5B E{ZS, T2, ap->in[I_SD] + (size_t)l * 1024};
                    pg8::gemm_phase<EpiS5B, pg8::SchedS5, false, true>(lds, g, S, E, tid);
                }
                __syncthreads();
                asm volatile("" : "+v"(tid));
                const int lane2 = tid & 63, wave2 = __builtin_amdgcn_readfirstlane(tid >> 6);
                LAS float* xsw = (LAS float*)(lds + wave2 * 2048);
                for (int it = bx * NWAVES + wave2; it < 128 * 64; it += G * NWAVES) s5_sample_item(ap, l, it >> 6, it & 63, ZS5S, T2, xsw, lane2);
                }
            } else if (sp == 3) { if constexpr (PH_ON(6)) {
                pg8::Gemm g{D, D, D}; pg8::SchedStd S; S.o.init(66, 12, G, bx); S.A0 = (const char*)Ua; S.A1 = (const char*)T2; S.asplit = 4; S.at = (size_t)256 * D * 2; S.bt = (size_t)256 * D * 2; S.B0 = (const char*)(ws + WS_W2);
                EpiG2 E{MAB};
                pg8::gemm_phase<EpiG2, pg8::SchedStd, true, true>(lds, g, S, E, tid); }
            } else if (sp == 4) { if constexpr (PH_ON(7)) {
                pg8::Gemm g{2048, 2048, 2048}; pg8::SchedStd S; S.o.init(66, 4, G, bx); S.A0 = S.A1 = (const char*)MAB; S.asplit = 1 << 30; S.at = (size_t)256 * 2048 * 2; S.bt = (size_t)256 * 2048 * 2; S.B0 = (const char*)(ws + WS_WOUT2);
                EpiRes E{xp, xs, adl + 2 * 1024, PRE};
                pg8::gemm_phase<EpiRes, pg8::SchedStd, true, true>(lds, g, S, E, tid); }
            } else if (sp == 5) { if constexpr (PH_ON(8)) {
                row_phase(1, PRE, PRE + (size_t)MP * D, yo, Ub, ap->in[I_LN1G] + (size_t)l * D, ap->in[I_LN1B] + (size_t)l * D, adl + 3 * 1024, adl + 4 * 1024, true, gw, NGW, lane);
                convert_ffn(ap, l, lds, gw, NGW, wave, lane); }
            } else if (sp == 6) { if constexpr (PH_ON(9)) {
                pg8::Gemm g{D, D, D}; pg8::SchedStd S; S.o.init(66, 22, G, bx); S.A0 = S.A1 = (const char*)Ub; S.asplit = 1 << 30; S.at = (size_t)256 * D * 2; S.bt = (size_t)256 * D * 2; S.B0 = (const char*)(ws + WS_WUP);
                EpiG4 E{HF};
                pg8::gemm_phase<EpiG4, pg8::SchedStd, true, true>(lds, g, S, E, tid); }
            } else if (sp == 7) { if constexpr (PH_ON(10)) {
                pg8::Gemm g{DFF, DFF, DFF}; pg8::SchedStd S; S.o.init(66, 4, G, bx); S.A0 = S.A1 = (const char*)HF; S.asplit = 1 << 30; S.at = (size_t)256 * DFF * 2; S.bt = (size_t)256 * DFF * 2; S.B0 = (const char*)(ws + WS_WDN);
                EpiRes E{yo, yo + (size_t)MP * D, adl + 5 * 1024, PRE};
                pg8::gemm_phase<EpiRes, pg8::SchedStd, true, true>(lds, g, S, E, tid); }
            } else { if constexpr (PH_ON(11)) {
                const bool more = (l + 1 < 2);
                row_phase(1, PRE, PRE + (size_t)MP * D, yo, Ub, ap->in[I_LN2G] + (size_t)l * D, ap->in[I_LN2B] + (size_t)l * D, adl + NADA + 0 * 1024, adl + NADA + 1 * 1024, more, gw, NGW, lane);
                if (more) { convert_main(ap, l + 1, false, lds, gw, NGW, wave, lane); __syncthreads(); if (bx < 64) s5_tables(ap, l + 1, bx, lds, tid); } }
            }
        }
}

__global__ void __launch_bounds__(NWAVES * 64, 2) hawk_fwd(Args args) {
    extern __shared__ __attribute__((aligned(16))) unsigned char lds_raw[];
    LAS unsigned char* lds = (LAS unsigned char*)lds_raw;
    volatile LAS unsigned* MISC = (volatile LAS unsigned*)(lds + MISC_OFF);
    const int G = gridDim.x, bx = blockIdx.x;
    for (int u = threadIdx.x; u < (LDS_BYTES - RING_BYTES) / 4; u += NWAVES * 64) ((LAS unsigned*)(lds + RING_BYTES))[u] = 0u;
    __syncthreads();
#if MK_ONE_LAUNCH
    XcdBarrier bar = xcd_barrier_post((unsigned*)(args.ws + WS_CTL) + 1024, MISC + 8);
#define SEAM(k) if ((k) + 1 < hi) xcd_barrier(bar);
#else
    (void)MISC;
#define SEAM(k)
#endif
    const int lo = args.ph_lo, hi = args.ph_hi;
#ifndef EXP_REP
#define EXP_REP(k) 0
#endif
#define RUN1(k) if (lo <= (k) && (k) < hi) { phase_body((k), lds, G, bx); SEAM(k) }
#define RUN(k) RUN1(k) if (EXP_REP(k)) { RUN1(k) }
    RUN(0) RUN(1) RUN(2)
    RUN(3) RUN(4) RUN(5) RUN(6) RUN(7) RUN(8) RUN(9) RUN(10) RUN(11)
    RUN(12) RUN(13) RUN(14) RUN(15) RUN(16) RUN(17) RUN(18) RUN(19) RUN(20)
#undef RUN
#undef RUN1
#undef SEAM
}

extern "C" void kernel_launch(void* const* d_in, const int* in_sizes, int n_in, void* d_out, int out_size, void* d_ws, size_t ws_size, hipStream_t stream) {
    static int grid = 0;
    if (grid == 0) {
        if (n_in != 34 || ws_size < WS_END) { fprintf(stderr, "kernel_launch: unexpected n_in %d / ws_size %zu (need %zu)\n", n_in, ws_size, (size_t)WS_END); grid = -1; return; }
        int dev = 0, cus = 0, per_cu = 0;
        (void)hipGetDevice(&dev); (void)hipDeviceGetAttribute(&cus, hipDeviceAttributeMultiprocessorCount, dev);
        if (hipFuncSetAttribute((const void*)hawk_fwd, hipFuncAttributeMaxDynamicSharedMemorySize, LDS_BYTES) != hipSuccess) { fprintf(stderr, "kernel_launch: hipFuncSetAttribute failed\n"); grid = -1; return; }
        if (hipOccupancyMaxActiveBlocksPerMultiprocessor(&per_cu, (const void*)hawk_fwd, NWAVES * 64, LDS_BYTES) != hipSuccess || per_cu < 1) { fprintf(stderr, "kernel_launch: occupancy query says %d\n", per_cu); per_cu = 1; }
        (void)hipGetLastError();
        grid = cus > 0 ? cus : 256;
    }
    if (grid < 0) return;
    (void)hipMemsetAsync((char*)d_ws + WS_CTL, 0, CTL_ZERO_BYTES, stream);
    Args a{};
    for (int i = 0; i < 34; ++i) a.in[i] = (const float*)d_in[i];
    a.out = (float*)d_out; a.ws = (unsigned char*)d_ws;
#if MK_ONE_LAUNCH
    a.ph_lo = 0; a.ph_hi = N_PHASES;
    void* kargs[] = {&a};
    hipError_t e = hipLaunchCooperativeKernel((const void*)hawk_fwd, dim3(grid), dim3(NWAVES * 64), kargs, LDS_BYTES, stream);
    if (e != hipSuccess) fprintf(stderr, "kernel_launch: cooperative launch failed: %s\n", hipGetErrorString(e));
#else
    for (int ph = 0; ph < N_PHASES; ++ph) { a.ph_lo = ph; a.ph_hi = ph + 1; hipLaunchKernelGGL(hawk_fwd, dim3(grid), dim3(NWAVES * 64), LDS_BYTES, stream, a); }
#endif
}
```
